# Optimizing an MI355X kernel written in HIP

```python
import math
import jax, jax.numpy as jnp
from jax import lax
import numpy as np

D_MODEL = 2048
BATCH = 1
SEQ = 8192
DEPTH = 1

D_MIX = D_MODEL
D_GMLP = D_MIX // 2
GMLP_GROUPS = 8
GMLP_GROUP_DIM = D_GMLP // GMLP_GROUPS
CHUNK = 128
D_ATTN = D_MIX - D_GMLP
HEAD_DIM = 128
N_HEADS = D_ATTN // HEAD_DIM
DILATED_BRANCHES = ((128, 1), (512, 4), (2048, 16))
MAX_DILATION = 16
BLK = 128
D_IN_PROJ = 2 * D_GMLP + 3 * D_ATTN
N_EXPERTS = 32
TOP_K = 4
D_EXPERT = D_MODEL
SWIGLU_LIMIT = 7.0
SWIGLU_ALPHA = 1.702
EXPERT_BLOCK = 128
LN_EPS = 1e-5
DEEPNORM_ALPHA = (2.0 * DEPTH) ** 0.25
DEEPNORM_BETA = (8.0 * DEPTH) ** -0.25

kernel_name = "hymba_gmlp_dilated_moe_block"


def layer_norm(x, g, b):
    xf = x.astype(jnp.float32)
    mu = jnp.mean(xf, axis=-1, keepdims=True)
    xc = xf - mu
    var = jnp.mean(xc * xc, axis=-1, keepdims=True)
    return (xc * lax.rsqrt(var + LN_EPS) * g + b).astype(x.dtype)


def gmlp_mixer(ua, va, ln_g, ln_b, w_s, b_s):
    B, S, _ = ua.shape
    n = S // CHUNK
    u = jax.nn.gelu(ua, approximate=False)
    v = jax.nn.gelu(va, approximate=False).reshape(B, n, CHUNK, GMLP_GROUPS, GMLP_GROUP_DIM)
    v = layer_norm(v, ln_g, ln_b)
    w = jnp.tril(w_s).astype(v.dtype)
    s = jnp.einsum('gts,bnsgc->bntgc', w, v) + b_s.T[None, None, :, :, None].astype(v.dtype)
    return u * s.reshape(B, S, D_GMLP)


def dilated_branch(q, k, v, slopes, window, dilation):
    B, H, Sp, hd = q.shape
    steps = window // dilation
    assert steps <= BLK
    L = Sp // dilation
    nb = L // BLK

    def to_res(t):
        return t.reshape(B, H, L, dilation, hd).transpose(0, 1, 3, 2, 4).reshape(B, H, dilation, nb, BLK, hd)

    qr, kr, vr = to_res(q), to_res(k), to_res(v)

    def with_prev(t):
        prev = jnp.pad(t[:, :, :, :-1], [(0, 0), (0, 0), (0, 0), (1, 0), (0, 0), (0, 0)])
        return jnp.concatenate([prev, t], axis=4)

    kb, vb = with_prev(kr), with_prev(vr)
    s = jnp.einsum('bhrnqc,bhrnkc->bhrnqk', qr, kb).astype(jnp.float32) * (hd ** -0.5)
    qi = jnp.arange(BLK)[:, None] + BLK
    ki = jnp.arange(2 * BLK)[None, :]
    step = qi - ki
    blk = jnp.arange(nb)[:, None, None]
    valid = (step >= 0) & (step <= steps) & ((blk > 0) | (ki >= BLK))
    dist = (step * dilation).astype(jnp.float32)
    s = s - slopes[None, :, None, None, None, None] * dist
    s = jnp.where(valid, s, -1e30)
    m = jnp.max(s, axis=-1, keepdims=True)
    p = jnp.exp(s - m)
    den = jnp.sum(p, axis=-1)
    o = jnp.einsum('bhrnqk,bhrnkc->bhrnqc', p.astype(vb.dtype), vb).astype(jnp.float32) / den[..., None]
    lse = m[..., 0] + jnp.log(den)
    o = o.reshape(B, H, dilation, L, hd).transpose(0, 1, 3, 2, 4).reshape(B, H, Sp, hd)
    lse = lse.reshape(B, H, dilation, L).transpose(0, 1, 3, 2).reshape(B, H, Sp)
    return o, lse


def dilated_attention(q, k, v):
    B, S, H, hd = q.shape
    span = MAX_DILATION * BLK
    Sp = -(-S // span) * span
    pad = [(0, 0), (0, Sp - S), (0, 0), (0, 0)]
    q, k, v = [jnp.pad(t, pad).transpose(0, 2, 1, 3) for t in (q, k, v)]
    slopes = jnp.exp2(-8.0 * jnp.arange(1, H + 1, dtype=jnp.float32) / H)
    outs, lses = [], []
    for window, dilation in DILATED_BRANCHES:
        o, lse = dilated_branch(q, k, v, slopes, window, dilation)
        outs.append(o)
        lses.append(lse)
    w = jax.nn.softmax(jnp.stack(lses, axis=0), axis=0)
    o = jnp.sum(w[..., None] * jnp.stack(outs, axis=0), axis=0)
    return o.transpose(0, 2, 1, 3)[:, :S].reshape(B, S, H * hd).astype(q.dtype)


def moe_ffn(h, w_router, b_router, w1, b1, w2, b2):
    B, S, D = h.shape
    N = B * S
    T = EXPERT_BLOCK
    xt = h.reshape(N, D)
    logits = (xt @ w_router + b_router).astype(jnp.float32)
    top_val, top_idx = lax.top_k(logits, TOP_K)
    gates = jax.nn.softmax(top_val, axis=-1)
    NK = N * TOP_K
    e_flat = top_idx.reshape(NK).astype(jnp.int32)
    g_flat = gates.reshape(NK)
    tok_flat = jnp.arange(NK, dtype=jnp.int32) // TOP_K
    order = jnp.argsort(e_flat)
    e_sorted, tok_sorted, g_sorted = e_flat[order], tok_flat[order], g_flat[order]
    counts = jnp.zeros((N_EXPERTS,), jnp.int32).at[e_flat].add(1)
    padded = (counts + T - 1) // T * T
    start = jnp.cumsum(counts) - counts
    pend = jnp.cumsum(padded)
    pstart = pend - padded
    dest = pstart[e_sorted] + jnp.arange(NK, dtype=jnp.int32) - start[e_sorted]
    cap = -(-NK // T) * T + N_EXPERTS * T
    n_blocks = cap // T
    buf_tok = jnp.full((cap,), N, jnp.int32).at[dest].set(tok_sorted)
    buf_gate = jnp.zeros((cap,), jnp.float32).at[dest].set(g_sorted)
    block_e = jnp.minimum(jnp.searchsorted(pend, jnp.arange(n_blocks, dtype=jnp.int32) * T, side='right'),
                          N_EXPERTS - 1)
    x_pad = jnp.concatenate([xt, jnp.zeros((1, D), xt.dtype)], axis=0)
    x_buf = x_pad[buf_tok].reshape(n_blocks, T, D)

    def run_block(args):
        xb, e = args
        h1 = xb @ w1[e] + b1[e]
        glu, lin = h1[:, :D_EXPERT], h1[:, D_EXPERT:]
        glu = jnp.minimum(glu, SWIGLU_LIMIT)
        lin = jnp.clip(lin, -SWIGLU_LIMIT, SWIGLU_LIMIT)
        act = glu * jax.nn.sigmoid(SWIGLU_ALPHA * glu) * (lin + 1.0)
        return act @ w2[e] + b2[e]

    out = lax.map(run_block, (x_buf, block_e)).reshape(cap, D)
    y = jnp.zeros((N + 1, D), jnp.float32).at[buf_tok].add(out.astype(jnp.float32) * buf_gate[:, None])[:N]
    return y.astype(h.dtype).reshape(B, S, D)


def setup_inputs(seed: int = 0) -> dict:
    key = jax.random.key(seed)
    ks = jax.random.split(key, 22)
    L = DEPTH

    def nrm(k, shape, scale):
        return jax.random.normal(k, shape, jnp.float32) * scale

    return {
        "x": nrm(ks[0], (BATCH, SEQ, D_MODEL), 1.0),
        "c": nrm(ks[1], (BATCH, D_MODEL), 1.0),
        "w_ada": nrm(ks[2], (L, D_MODEL, 6 * D_MODEL), 0.5 * D_MODEL ** -0.5),
        "b_ada": nrm(ks[3], (L, 6 * D_MODEL), 0.02),
        "w_in": nrm(ks[4], (L, D_MODEL, D_IN_PROJ), D_MODEL ** -0.5),
        "sgu_ln_g": 1.0 + nrm(ks[5], (L, GMLP_GROUPS, GMLP_GROUP_DIM), 0.02),
        "sgu_ln_b": nrm(ks[6], (L, GMLP_GROUPS, GMLP_GROUP_DIM), 0.02),
        "w_spatial": nrm(ks[7], (L, GMLP_GROUPS, CHUNK, CHUNK), 0.5 * CHUNK ** -0.5),
        "b_spatial": 1.0 + nrm(ks[8], (L, GMLP_GROUPS, CHUNK), 0.02),
        "w_o": nrm(ks[9], (L, D_MIX, D_MODEL), DEEPNORM_BETA * D_MIX ** -0.5),
        "ln1_g": 1.0 + nrm(ks[10], (L, D_MODEL), 0.02),
        "ln1_b": nrm(ks[11], (L, D_MODEL), 0.02),
        "w_router": nrm(ks[12], (L, D_MODEL, N_EXPERTS), D_MODEL ** -0.5),
        "b_router": nrm(ks[13], (L, N_EXPERTS), 0.01),
        "w_exp1": nrm(ks[14], (L, N_EXPERTS, D_MODEL, 2 * D_EXPERT), D_MODEL ** -0.5),
        "b_exp1": nrm(ks[15], (L, N_EXPERTS, 2 * D_EXPERT), 0.02),
        "w_exp2": nrm(ks[16], (L, N_EXPERTS, D_EXPERT, D_MODEL), DEEPNORM_BETA * D_EXPERT ** -0.5),
        "b_exp2": nrm(ks[17], (L, N_EXPERTS, D_MODEL), 0.02),
        "ln2_g": 1.0 + nrm(ks[18], (L, D_MODEL), 0.02),
        "ln2_b": nrm(ks[19], (L, D_MODEL), 0.02),
    }


def reference(x, c, w_ada, b_ada, w_in, sgu_ln_g, sgu_ln_b, w_spatial, b_spatial, w_o, ln1_g, ln1_b,
              w_router, b_router, w_exp1, b_exp1, w_exp2, b_exp2, ln2_g, ln2_b):
    B, S, D = x.shape
    splits = [D_GMLP, 2 * D_GMLP, 2 * D_GMLP + D_ATTN, 2 * D_GMLP + 2 * D_ATTN]
    for l in range(DEPTH):
        ada = jax.nn.silu(c) @ w_ada[l] + b_ada[l]
        shift1, scale1, gate1, shift2, scale2, gate2 = jnp.split(ada[:, None, :], 6, axis=-1)

        h = x * (1.0 + scale1) + shift1
        proj = h @ w_in[l]
        ua, va, q, k, v = jnp.split(proj, splits, axis=-1)
        y_a = gmlp_mixer(ua, va, sgu_ln_g[l], sgu_ln_b[l], w_spatial[l], b_spatial[l])
        y_b = dilated_attention(q.reshape(B, S, N_HEADS, HEAD_DIM),
                                k.reshape(B, S, N_HEADS, HEAD_DIM),
                                v.reshape(B, S, N_HEADS, HEAD_DIM))
        mix = jnp.concatenate([y_a, y_b], axis=-1) @ w_o[l]
        x = layer_norm(DEEPNORM_ALPHA * x + gate1 * mix, ln1_g[l], ln1_b[l])

        h = x * (1.0 + scale2) + shift2
        y = moe_ffn(h, w_router[l], b_router[l], w_exp1[l], b_exp1[l], w_exp2[l], b_exp2[l])
        x = layer_norm(DEEPNORM_ALPHA * x + gate2 * y, ln2_g[l], ln2_b[l])
    return x
```

```cpp
#include <hip/hip_runtime.h>
#include <cstdio>
#include <cstdint>

#ifndef MK_N_LAUNCHES
#define MK_N_LAUNCHES 1
#endif

#ifndef MK_ABL8
#define MK_ABL8 -1
#endif
#ifndef MK_DUP_MASK
#define MK_DUP_MASK 0
#endif
#define NREP(k) ((((MK_DUP_MASK) >> (k)) & 1) ? 2 : 1)
#define GAS __attribute__((address_space(1)))
#define LAS __attribute__((address_space(3)))
typedef unsigned short bf16_t;
typedef short bf16x8 __attribute__((ext_vector_type(8)));
typedef float f32x4 __attribute__((ext_vector_type(4)));
typedef float f32x2 __attribute__((ext_vector_type(2)));
typedef unsigned u32x4 __attribute__((ext_vector_type(4)));
typedef unsigned u32x2 __attribute__((ext_vector_type(2)));
typedef GAS unsigned gu32;

constexpr int S = 8192, D = 2048, NPROJ = 5120, DG = 1024, NH = 8, HD = 128, NE = 32, TOPK = 4, DE = 2048, NW1 = 4096;
constexpr int CAP_TILES = 160, CAP = CAP_TILES * 256;
constexpr float LN_EPS = 1e-5f;
constexpr float ALPHA = 1.189207115002721f;
constexpr float LOG2E = 1.4426950408889634f;
constexpr float QSCALE = 0.08838834764831845f * LOG2E;
constexpr int NWAVES = 8, NTHR = 512;

constexpr size_t MiB = 1u << 20;
constexpr size_t WS_CTL = 0, CTL_ZERO_BYTES = 32768;
constexpr size_t WS_WIN = 2 * MiB;
constexpr size_t WS_WO = 22 * MiB;
constexpr size_t WS_SMALL = 30 * MiB;
constexpr size_t WS_H = 32 * MiB;
constexpr size_t WS_PROJ = 64 * MiB;
constexpr size_t WS_OB = 144 * MiB;
constexpr size_t WS_Y = 192 * MiB;
constexpr size_t WS_Z = 224 * MiB;
constexpr size_t WS_X1 = 288 * MiB;
constexpr size_t WS_H2 = 352 * MiB;
constexpr size_t WS_ACT = 386 * MiB;
constexpr size_t WS_CONTRIB = 546 * MiB;
constexpr size_t WS_PADA = 1474 * MiB;
constexpr size_t WS_END = 1476 * MiB;
constexpr size_t SM_TOPI = 0, SM_TOPG = 128 * 1024, SM_RBC = 256 * 1024, SM_TOK = 320 * 1024, SM_GATEP = 480 * 1024, SM_POSOF = 640 * 1024, SM_TEXP = 768 * 1024, SM_LSE = 1024 * 1024;
constexpr int CW_TMO = 0, CW_CODE = 1, CW_BAR = 4096;
static_assert((CW_BAR + 3456) * 4 <= (int)CTL_ZERO_BYTES, "barrier words inside the memset region");

constexpr int RING_BYTES = 131072;
constexpr int LDS_BYTES = 147456;
constexpr int ROWTAB_OFF = RING_BYTES;
constexpr int TEXP_OFF = ROWTAB_OFF + 12 * 1024;
constexpr int MISC_OFF = LDS_BYTES - 512;
static_assert(TEXP_OFF + 2048 <= MISC_OFF && CAP_TILES <= 256, "LDS map");

#define RLX_AGENT __ATOMIC_RELAXED, __HIP_MEMORY_SCOPE_AGENT
#define LDS_WAIT() asm volatile("s_waitcnt lgkmcnt(0)" ::: "memory")
#define VM_WAIT() asm volatile("s_waitcnt vmcnt(0)" ::: "memory")
__device__ __forceinline__ unsigned f2bf(float f) { unsigned u = __builtin_bit_cast(unsigned, f); return (u + 0x7fffu + ((u >> 16) & 1u)) >> 16; }
__device__ __forceinline__ unsigned pk2(float lo, float hi) { return f2bf(lo) | (f2bf(hi) << 16); }
typedef _Float16 h16x2 __attribute__((ext_vector_type(2)));
typedef _Float16 h16x8 __attribute__((ext_vector_type(8)));
__device__ __forceinline__ float h2f1(unsigned short h) { return (float)__builtin_bit_cast(_Float16, h); }
__device__ __forceinline__ f32x4 uph4(u32x2 t) { const unsigned w0 = t.x, w1 = t.y; f32x4 r; r[0] = h2f1((unsigned short)(w0 & 0xffffu)); r[1] = h2f1((unsigned short)(w0 >> 16)); r[2] = h2f1((unsigned short)(w1 & 0xffffu)); r[3] = h2f1((unsigned short)(w1 >> 16)); return r; }
__device__ __forceinline__ unsigned r8h(unsigned w) { return (w + 0x00040004u) & 0xfff8fff8u; }
__device__ __forceinline__ unsigned pkh(float lo, float hi) { h16x2 v; v.x = (_Float16)lo; v.y = (_Float16)hi; return __builtin_bit_cast(unsigned, v); }
__device__ __forceinline__ float bflo(unsigned p) { return __uint_as_float(p << 16); }
__device__ __forceinline__ float bfhi(unsigned p) { return __uint_as_float(p & 0xffff0000u); }
__device__ __forceinline__ float bf1(bf16_t b) { return __uint_as_float((unsigned)b << 16); }
__device__ __forceinline__ f32x4 ldf4(const void* base, unsigned byteoff) { return *(const f32x4*)((const char*)base + byteoff); }
__device__ __forceinline__ u32x2 ldu2(const void* base, unsigned byteoff) { return *(const u32x2*)((const char*)base + byteoff); }
__device__ __forceinline__ float wave_sum(float v) {
#define WS_DPP(x, ctrl, rmask) __builtin_bit_cast(float, __builtin_amdgcn_update_dpp(0, __builtin_bit_cast(int, x), ctrl, rmask, 0xF, false))
    v += WS_DPP(v, 0xB1, 0xF);
    v += WS_DPP(v, 0x4E, 0xF);
    v += WS_DPP(v, 0x141, 0xF);
    v += WS_DPP(v, 0x140, 0xF);
    v += WS_DPP(v, 0x142, 0xA);
    v += WS_DPP(v, 0x143, 0xC);
#undef WS_DPP
    return __builtin_bit_cast(float, __builtin_amdgcn_readlane(__builtin_bit_cast(int, v), 63));
}
__device__ __forceinline__ float wave_max(float v) {
#pragma unroll
    for (int o = 1; o < 64; o <<= 1) v = fmaxf(v, __shfl_xor(v, o));
    return v;
}

typedef short s16x4 __attribute__((ext_vector_type(4)));
__device__ __forceinline__ s16x4 ds_tr16(const LAS unsigned char* p) { return __builtin_bit_cast(s16x4, __builtin_amdgcn_ds_read_tr16_b64_v4i16((LAS s16x4*)p)); }

namespace pg8 {
#define PG8_LAS __attribute__((address_space(3)))
constexpr int BM = 256, BK = 64, HALF = 128, HTB = HALF * BK * 2, STAGE_BYTES = 8 * HTB, NXCD = 8, WGM = 8;
__host__ __device__ __forceinline__ int lds_byte(int r, int c) { const int st = (r >> 4) * 2 + (c >> 5), rr = r & 15, cc = c & 31, ob = rr * 64 + cc * 2; return st * 1024 + (ob ^ (((ob >> 9) & 1) << 5)); }
__host__ __device__ __forceinline__ void stage_rc(int b, int& R, int& C) { const int st = b / 1024, sb = b % 1024, swz = sb ^ (((sb >> 9) & 1) << 5); R = (st >> 1) * 16 + swz / 64; C = (st & 1) * 32 + (swz % 64) / 2; }
__host__ __device__ __forceinline__ int perm32(int rho) { const int n = rho >> 4, i = rho & 15; return 8 * (i >> 2) + 4 * n + (i & 3); }

struct Unit { int pm, pn, arow, brow, e, hn, nv; };
struct Gemm { const bf16_t* A; const bf16_t* Bt; int K; };

__device__ __forceinline__ void tile_of(int L, int nM, int nN, int& pm, int& pn) {
    const int nwg = nM * nN; int wgid = L;
    { const int q = nwg / NXCD, r = nwg % NXCD, xcd = wgid % NXCD, off = wgid / NXCD; wgid = (xcd < r ? xcd * (q + 1) : r * (q + 1) + (xcd - r) * q) + off; }
    const int nig = WGM * nN, gid = wgid / nig, fm = gid * WGM, gsz = (nM - fm) < WGM ? (nM - fm) : WGM;
    pm = fm + ((wgid % nig) % gsz); pn = (wgid % nig) / gsz;
}
struct DenseOrder {
    int nM, nN, G, c, cnt;
    __device__ __forceinline__ bool next(int i, Unit& u) const {
        const int L = i * G + c; if (L >= cnt) return false;
        tile_of(L, nM, nN, u.pm, u.pn); u.arow = u.pm * BM; u.brow = u.pn * BM; u.e = 0; u.hn = -1; u.nv = BM; return true;
    }
};
struct HalfOrder {
    int nM, nN, G, c, L0;
    __device__ __forceinline__ bool next(int i, Unit& u) const {
        const int Lh = i * G + c; if (Lh >= 2 * (nM * nN - L0)) return false;
        tile_of(L0 + (Lh >> 1), nM, nN, u.pm, u.pn); u.hn = Lh & 1; u.arow = u.pm * BM; u.brow = u.pn * BM + u.hn * HALF; u.e = 0; u.nv = BM; return true;
    }
};
struct MoeOrder {
    int nM, nN, G, c, N; const LAS int* texp;
    __device__ __forceinline__ bool next(int i, Unit& u) const {
        const int L = i * G + c, nwg = nM * nN; if (L >= nwg) return false;
        int wgid = L; { const int q = nwg / NXCD, r = nwg % NXCD, xcd = wgid % NXCD, off = wgid / NXCD; wgid = (xcd < r ? xcd * (q + 1) : r * (q + 1) + (xcd - r) * q) + off; }
        const int t0 = wgid >> __builtin_ctz(nN), w1 = __builtin_amdgcn_readfirstlane(texp[t0]), w2 = __builtin_amdgcn_readfirstlane(texp[256 + t0]);
        const int e = w1 & 255, lo = t0 - (w2 & 255), R = (w2 >> 8) & 255, idx = wgid - lo * nN;
        const int pn_ = (int)(((float)idx + 0.5f) * __builtin_amdgcn_rcpf((float)R));
        u.pn = pn_; u.pm = lo + idx - pn_ * R; u.arow = u.pm * BM; u.e = e; u.brow = e * N + u.pn * BM; u.hn = -1; u.nv = (u.pm == lo + R - 1) ? ((w2 >> 16) & 511) : BM; return true;
    }
};

__device__ __forceinline__ unsigned cvt_pk_bf16(float lo, float hi) { unsigned r; asm volatile("v_cvt_pk_bf16_f32 %0, %1, %2" : "=v"(r) : "v"(lo), "v"(hi)); return r; }
__device__ __forceinline__ f32x2 gelu_pk(f32x2 v) {
    const f32x2 av = __builtin_elementwise_abs(v), d = av * 0.2316418882f + 1.0f;
    f32x2 t; t.x = __builtin_amdgcn_rcpf(d.x); t.y = __builtin_amdgcn_rcpf(d.y);
    f32x2 q = t * 0.5307027145f + (-0.7265760135f); q = q * t + 0.7107068705f; q = q * t + (-0.142248368f); q = q * t + 0.127414796f; q = q * t;
    const f32x2 s = (v * v) * (-0.72134752044f);
    f32x2 e; e.x = __builtin_amdgcn_exp2f(s.x); e.y = __builtin_amdgcn_exp2f(s.y);
    const f32x2 m = v * (q * e), r = v - m;
    f32x2 o; o.x = v.x < 0.f ? m.x : r.x; o.y = v.y < 0.f ? m.y : r.y; return o;
}

struct EpiProj {
    static constexpr bool PERM = true;
    bf16_t* O;
    __device__ __forceinline__ void operator()(const f32x4 (&acc)[2][2][4][2], const Unit& u, int wr, int wc, int fr, int fq) const {
        const int row0 = u.pm * BM + wr * 64 + fr, col0 = u.pn * BM + wc * 32 + 8 * fq + (u.hn > 0 ? HALF : 0);
        const int mode = u.pn < 8 ? 1 : (u.pn < 12 ? 2 : 0), nbj = u.hn < 0 ? 2 : 1;
#pragma unroll
        for (int ai = 0; ai < 2; ++ai)
#pragma unroll
            for (int m = 0; m < 4; ++m) { bf16_t* rowp = O + (size_t)(row0 + ai * HALF + m * 16) * NPROJ + col0;
#pragma unroll
                for (int bj = 0; bj < 2; ++bj) { if (bj >= nbj) continue; f32x4 v0 = acc[ai][bj][m][0], v1 = acc[ai][bj][m][1];
                    if (mode == 1) { f32x2 a = gelu_pk((f32x2){v0[0], v0[1]}), b = gelu_pk((f32x2){v0[2], v0[3]}), c = gelu_pk((f32x2){v1[0], v1[1]}), d = gelu_pk((f32x2){v1[2], v1[3]});
                        v0 = (f32x4){a.x, a.y, b.x, b.y}; v1 = (f32x4){c.x, c.y, d.x, d.y}; }
                    else if (mode == 2) { v0 = v0 * QSCALE; v1 = v1 * QSCALE; }
                    u32x4 w; w.x = cvt_pk_bf16(v0[0], v0[1]); w.y = cvt_pk_bf16(v0[2], v0[3]); w.z = cvt_pk_bf16(v1[0], v1[1]); w.w = cvt_pk_bf16(v1[2], v1[3]);
                    *(u32x4*)(rowp + bj * HALF) = w; } }
    }
};
struct EpiZ {
    static constexpr bool PERM = false;
    bf16_t* Z; const float* x; const float* ada;
    __device__ __forceinline__ void operator()(const f32x4 (&acc)[2][2][4][2], const Unit& u, int wr, int wc, int fr, int fq) const {
        const int row0 = u.pm * BM + wr * 64 + fr, col0 = u.pn * BM + wc * 32 + 4 * fq;
        f32x4 gv[2][2];
#pragma unroll
        for (int bj = 0; bj < 2; ++bj)
#pragma unroll
            for (int n = 0; n < 2; ++n) gv[bj][n] = *(const f32x4*)(ada + 2 * D + col0 + bj * HALF + n * 16);
        f32x4 xg[2][2][2][2];
#define EZ_LD(buf, g) do { _Pragma("unroll") for (int s = 0; s < 2; ++s) { const int ai = ((g) * 2 + s) >> 2, m = ((g) * 2 + s) & 3; const size_t off = (size_t)(row0 + ai * HALF + m * 16) * D + col0; \
            _Pragma("unroll") for (int bj = 0; bj < 2; ++bj) _Pragma("unroll") for (int n = 0; n < 2; ++n) xg[buf][s][bj][n] = *(const f32x4*)(x + off + bj * HALF + n * 16); } } while (0)
        EZ_LD(0, 0);
#pragma unroll
        for (int g = 0; g < 4; ++g) {
            if (g + 1 < 4) EZ_LD((g + 1) & 1, g + 1);
            asm volatile("" : "+v"(xg[g & 1][0][0][0]), "+v"(xg[g & 1][0][0][1]), "+v"(xg[g & 1][0][1][0]), "+v"(xg[g & 1][0][1][1]), "+v"(xg[g & 1][1][0][0]), "+v"(xg[g & 1][1][0][1]), "+v"(xg[g & 1][1][1][0]), "+v"(xg[g & 1][1][1][1]));
#pragma unroll
            for (int s = 0; s < 2; ++s) { const int ai = (g * 2 + s) >> 2, m = (g * 2 + s) & 3; const size_t off = (size_t)(row0 + ai * HALF + m * 16) * D + col0;
#pragma unroll
                for (int bj = 0; bj < 2; ++bj)
#pragma unroll
                    for (int n = 0; n < 2; ++n) { const f32x4 zv = xg[g & 1][s][bj][n] * ALPHA + gv[bj][n] * acc[ai][bj][m][n];
                        u32x2 w; w.x = pkh(zv[0], zv[1]); w.y = pkh(zv[2], zv[3]); *(u32x2*)(Z + off + bj * HALF + n * 16) = w; } }
        }
#undef EZ_LD
    }
};
struct EpiSwiglu {
    static constexpr bool PERM = true;
    bf16_t* O; const float* b1; int wrs, ais;
    static constexpr int NDMA = 1;
    __device__ __forceinline__ const float* dma_base(const Unit& u, int) const { return b1 + (size_t)u.e * NW1 + u.pn * HALF; }
    __device__ __forceinline__ unsigned dma_off(int, int l) const { return (unsigned)(l < 32 ? 16 * l : 4 * DE + 16 * (l - 32)); }
    __device__ __forceinline__ void operator()(const f32x4 (&acc)[2][2][4][2], const Unit& u, int wr, int wc, int fr, int fq, const PG8_LAS float* lb) const {
        const int row0 = u.pm * BM + wr * wrs + fr, jc = u.pn * HALF + wc * 32 + 8 * fq;
        f32x4 bg[2], bl[2];
#pragma unroll
        for (int n = 0; n < 2; ++n) { bg[n] = *(const PG8_LAS f32x4*)(lb + wc * 32 + 8 * fq + 4 * n); bl[n] = *(const PG8_LAS f32x4*)(lb + HALF + wc * 32 + 8 * fq + 4 * n); }
#pragma unroll
        for (int ai = 0; ai < 2; ++ai)
#pragma unroll
            for (int m = 0; m < 4; ++m) { bf16_t* rowp = O + (size_t)(row0 + ai * ais + m * 16) * DE + jc;
                f32x4 o[2];
#pragma unroll
                for (int n = 0; n < 2; ++n) { const f32x4 g = acc[ai][0][m][n] + bg[n], l = acc[ai][1][m][n] + bl[n];
#pragma unroll
                    for (int j = 0; j < 4; ++j) { const float gg = fminf(g[j], 7.0f), ll = fminf(fmaxf(l[j], -7.0f), 7.0f);
                        const float sg = __builtin_amdgcn_rcpf(1.0f + __builtin_amdgcn_exp2f(gg * (-1.702f * LOG2E)));
                        o[n][j] = gg * sg * (ll + 1.0f); } }
                u32x4 w; w.x = r8h(pkh(o[0][0], o[0][1])); w.y = r8h(pkh(o[0][2], o[0][3])); w.z = r8h(pkh(o[1][0], o[1][1])); w.w = r8h(pkh(o[1][2], o[1][3]));
                if (wr * wrs + fr + ai * ais + m * 16 >= u.nv) w = (u32x4){0u, 0u, 0u, 0u};
                *(u32x4*)rowp = w; }
    }
};
struct EpiContrib {
    static constexpr bool PERM = true;
    bf16_t* O; const float* b2; const float* gate; int wrs, ais;
    static constexpr int NDMA = 2;
    __device__ __forceinline__ const float* dma_base(const Unit& u, int piece) const { return piece == 0 ? b2 + (size_t)u.e * D + u.pn * BM : gate + (size_t)u.pm * BM; }
    __device__ __forceinline__ unsigned dma_off(int, int l) const { return (unsigned)(16 * l); }
    __device__ __forceinline__ void operator()(const f32x4 (&acc)[2][2][4][2], const Unit& u, int wr, int wc, int fr, int fq, const PG8_LAS float* lb) const {
        const int row0 = u.pm * BM + wr * wrs + fr, col0 = u.pn * BM + wc * 32 + 8 * fq;
        f32x4 bv[2][2];
#pragma unroll
        for (int bj = 0; bj < 2; ++bj)
#pragma unroll
            for (int n = 0; n < 2; ++n) bv[bj][n] = *(const PG8_LAS f32x4*)(lb + bj * HALF + wc * 32 + 8 * fq + 4 * n);
        float gtv[2][4];
#pragma unroll
        for (int ai = 0; ai < 2; ++ai)
#pragma unroll
            for (int m = 0; m < 4; ++m) gtv[ai][m] = lb[256 + wr * wrs + fr + ai * ais + m * 16];
#pragma unroll
        for (int ai = 0; ai < 2; ++ai)
#pragma unroll
            for (int m = 0; m < 4; ++m) { const int row = row0 + ai * ais + m * 16; const float gt = gtv[ai][m]; bf16_t* rowp = O + (size_t)row * D + col0;
#pragma unroll
                for (int bj = 0; bj < 2; ++bj) { const f32x4 v0 = (acc[ai][bj][m][0] + bv[bj][0]) * gt, v1 = (acc[ai][bj][m][1] + bv[bj][1]) * gt;
                    u32x4 w; w.x = cvt_pk_bf16(v0[0], v0[1]); w.y = cvt_pk_bf16(v0[2], v0[3]); w.z = cvt_pk_bf16(v1[0], v1[1]); w.w = cvt_pk_bf16(v1[2], v1[3]);
                    if (gt != 0.f) *(u32x4*)(rowp + bj * HALF) = w; } }
    }
};

template <class Epi, class Sched, bool GATHER, bool HN = false>
__device__ __forceinline__ void gemm_phase(PG8_LAS unsigned char* lds, const Gemm g, const Sched& S, const Epi& E, const PG8_LAS unsigned* rowtab) {
    const int tid = threadIdx.x, wid = __builtin_amdgcn_readfirstlane(tid >> 6), lane = tid & 63, wr = wid >> 2, wc = wid & 3, fr = lane & 15, fq = lane >> 4;
    const int K = g.K, nt = K / BK;
    int rA[2]; unsigned cA2[2], voffB[2];
#pragma unroll
    for (int i = 0; i < 2; ++i) { int R, C; stage_rc(tid * 16 + i * 8192, R, C); const int Rb = Epi::PERM ? ((R & ~31) + perm32(R & 31)) : R;
        rA[i] = R; cA2[i] = (unsigned)C * 2u; voffB[i] = (unsigned)(Rb * K + C) * 2u; }
    const size_t kstep = (size_t)(BK * 2);
    const size_t hstep = HN ? (size_t)0 : (size_t)HALF * K * 2;
    const unsigned ldsw = (unsigned)wid * 1024u;
    const int aoff = lds_byte(wr * 64 + fr, fq * 8), boff = lds_byte(wc * 32 + fr, fq * 8);
#define PG8_SA(b, h) (((b) * 2 + (h)) * HTB)
#define PG8_SB(b, h) ((4 + (b) * 2 + (h)) * HTB)
#define PG8_STAGE(bufoff, gbase, voff) do { _Pragma("unroll") for (int _i = 0; _i < 2; ++_i) \
        __builtin_amdgcn_global_load_lds((const unsigned*)((const char*)(gbase) + (voff)[_i]), (PG8_LAS unsigned*)(lds + (bufoff) + ldsw + _i * 8192), 16, 0, 0); } while (0)
#define PG8_LDA(dst, b, h) do { _Pragma("unroll") for (int m = 0; m < 4; ++m) _Pragma("unroll") for (int k = 0; k < 2; ++k) dst[m][k] = *(const PG8_LAS bf16x8*)(lds + PG8_SA(b, h) + aoff + m * 2048 + k * 1024); } while (0)
#define PG8_LDB(dst, b, h) do { _Pragma("unroll") for (int n = 0; n < 2; ++n) _Pragma("unroll") for (int k = 0; k < 2; ++k) dst[n][k] = *(const PG8_LAS bf16x8*)(lds + PG8_SB(b, h) + boff + n * 2048 + k * 1024); } while (0)
#define PG8_MMA(ai, bj, At, Bt) do { __builtin_amdgcn_s_setprio(1); _Pragma("unroll") for (int m = 0; m < 4; ++m) _Pragma("unroll") for (int n = 0; n < 2; ++n) _Pragma("unroll") for (int k = 0; k < 2; ++k) \
        acc[ai][bj][m][n] = __builtin_amdgcn_mfma_f32_16x16x32_bf16(Bt[n][k], At[m][k], acc[ai][bj][m][n], 0, 0, 0); __builtin_amdgcn_s_setprio(0); } while (0)
#define PG8_WAIT_V(n) asm volatile("s_waitcnt vmcnt(" #n ")" ::: "memory")
#define PG8_WAIT_L(n) asm volatile("s_waitcnt lgkmcnt(" #n ")" ::: "memory")
#define PG8_BAR __builtin_amdgcn_s_barrier()
#define PG8_SCHED __builtin_amdgcn_sched_barrier(0)
#define PG8_AOFF(dst, un, uidx) do { _Pragma("unroll") for (int _h = 0; _h < 2; ++_h) _Pragma("unroll") for (int _i = 0; _i < 2; ++_i) \
        dst[_h][_i] = (GATHER ? rowtab[(uidx) * 256 + _h * HALF + rA[_i]] : (unsigned)((un).arow + _h * HALF + rA[_i]) * (unsigned)(K * 2)) + cA2[_i]; } while (0)
    Unit cur, nxt; int ui = 0;
    if (!S.next(0, cur)) return;
    f32x4 acc[2][2][4][2];
#pragma unroll
    for (int a = 0; a < 2; ++a)
#pragma unroll
        for (int b = 0; b < 2; ++b)
#pragma unroll
            for (int m = 0; m < 4; ++m)
#pragma unroll
                for (int n = 0; n < 2; ++n) acc[a][b][m][n] = (f32x4){0.f, 0.f, 0.f, 0.f};
    bf16x8 At[4][2], B0[2][2], B1[2][2];
    unsigned oA[2][2], oN[2][2];
    PG8_AOFF(oA, cur, 0);
#pragma unroll
    for (int h = 0; h < 2; ++h) { oN[h][0] = oA[h][0]; oN[h][1] = oA[h][1]; }
    const char* const gA = (const char*)g.A;
    const char* cB = (const char*)g.Bt + (size_t)cur.brow * K * 2;
    PG8_STAGE(PG8_SB(0, 0), cB, voffB); PG8_STAGE(PG8_SB(0, 1), cB + hstep, voffB); PG8_STAGE(PG8_SA(0, 0), gA, oA[0]); PG8_STAGE(PG8_SA(0, 1), gA, oA[1]);
    if (wr == 1) PG8_BAR;
    PG8_WAIT_V(2); PG8_BAR;
    PG8_STAGE(PG8_SB(1, 0), cB + kstep, voffB); PG8_STAGE(PG8_SA(1, 0), gA + kstep, oA[0]); PG8_STAGE(PG8_SB(1, 1), cB + hstep + kstep, voffB);
    PG8_WAIT_V(6); PG8_BAR;
    for (;;) {
        const bool has_next = S.next(ui + 1, nxt);
        const char* nB = has_next ? (const char*)g.Bt + (size_t)nxt.brow * K * 2 : cB;
        for (int t = 0; t < nt; t += 2) {
            const bool last = (t == nt - 2);
            if (last && has_next) PG8_AOFF(oN, nxt, ui + 1);
            const char* a1 = gA + (size_t)(t + 1) * kstep;
            const char* a2 = last ? gA : gA + (size_t)(t + 2) * kstep; const char* b2 = last ? nB : cB + (size_t)(t + 2) * kstep;
            const char* a3 = a2 + kstep; const char* b3 = b2 + kstep;
            unsigned o2[2][2];
#pragma unroll
            for (int h = 0; h < 2; ++h) { o2[h][0] = last ? oN[h][0] : oA[h][0]; o2[h][1] = last ? oN[h][1] : oA[h][1]; }
            PG8_LDB(B0, 0, 0); if (!HN) PG8_LDB(B1, 0, 1); PG8_SCHED; PG8_LDA(At, 0, 0); PG8_STAGE(PG8_SA(1, 1), a1, oA[1]);
            PG8_WAIT_V(8); PG8_WAIT_L(0); PG8_BAR; PG8_MMA(0, 0, At, B0); if (!HN) PG8_MMA(0, 1, At, B1); PG8_BAR; PG8_SCHED;
            PG8_LDA(At, 0, 1); PG8_STAGE(PG8_SB(0, 0), b2, voffB); PG8_STAGE(PG8_SB(0, 1), b2 + hstep, voffB); PG8_STAGE(PG8_SA(0, 0), a2, o2[0]);
            PG8_WAIT_V(8); PG8_WAIT_L(0); PG8_BAR; PG8_MMA(1, 0, At, B0); if (!HN) PG8_MMA(1, 1, At, B1); PG8_BAR; PG8_SCHED;
            PG8_LDB(B0, 1, 0); if (!HN) PG8_LDB(B1, 1, 1); PG8_SCHED; PG8_LDA(At, 1, 0); PG8_STAGE(PG8_SA(0, 1), a2, o2[1]);
            PG8_WAIT_V(8); PG8_WAIT_L(0); PG8_BAR; PG8_MMA(0, 0, At, B0); if (!HN) PG8_MMA(0, 1, At, B1); PG8_BAR; PG8_SCHED;
            PG8_LDA(At, 1, 1); PG8_STAGE(PG8_SB(1, 0), b3, voffB); PG8_STAGE(PG8_SB(1, 1), b3 + hstep, voffB); PG8_STAGE(PG8_SA(1, 0), a3, o2[0]);
            PG8_WAIT_V(8); PG8_WAIT_L(0); PG8_BAR; PG8_MMA(1, 0, At, B0); if (!HN) PG8_MMA(1, 1, At, B1); PG8_BAR; PG8_SCHED;
        }
        if (wr == 0) PG8_BAR;
        E(acc, cur, wr, wc, fr, fq);
        if (!has_next) break;
#pragma unroll
        for (int a = 0; a < 2; ++a)
#pragma unroll
            for (int b = 0; b < 2; ++b)
#pragma unroll
                for (int m = 0; m < 4; ++m)
#pragma unroll
                    for (int n = 0; n < 2; ++n) acc[a][b][m][n] = (f32x4){0.f, 0.f, 0.f, 0.f};
        cur = nxt; cB = nB; ++ui;
#pragma unroll
        for (int h = 0; h < 2; ++h) { oA[h][0] = oN[h][0]; oA[h][1] = oN[h][1]; }
        if (wr == 1) PG8_BAR;
    }
    PG8_WAIT_V(0);
    PG8_BAR;
#undef PG8_SA
#undef PG8_SB
#undef PG8_STAGE
#undef PG8_LDA
#undef PG8_LDB
#undef PG8_MMA
#undef PG8_WAIT_V
#undef PG8_WAIT_L
#undef PG8_BAR
#undef PG8_SCHED
#undef PG8_AOFF
}
}


namespace rg {
constexpr int A_BUF = 32768, BROW = 576, B_BUF = 64 * BROW, B_OFF = 2 * A_BUF, EPI_OFF = B_OFF + 2 * B_BUF, EPI_SLOT = 2048;
static_assert(EPI_OFF + 2 * EPI_SLOT <= 143360, "LDS");
template <class Epi, class Sched, bool G1, int ABL = 0>
__device__ __forceinline__ void moe_gemm(LAS unsigned char* lds, const Sched& S, const Epi& E, const bf16_t* A, const int* tok, const float* W, int N) {
    constexpr int K = 2048, nt = K / 64;
    const int tid = threadIdx.x, wid = __builtin_amdgcn_readfirstlane(tid >> 6), lane = tid & 63, wr = wid >> 2, wc = wid & 3, fr = lane & 15, fq = lane >> 4;
    const unsigned bwr = (unsigned)(8 * wid * BROW) + (unsigned)(8 * lane);
    const unsigned bsw = (unsigned)((wid & 1) << 3);
    const unsigned ard = (unsigned)((128 * wr + fr) * 128) + (unsigned)((fq ^ ((fr >> 1) & 7)) << 4);
    const unsigned brd = (unsigned)((8 * fq + (fr >> 2)) * BROW) + (unsigned)(((64 * wc + 16 * (fr & 3))) ^ ((fq & 1) << 3));
    const unsigned lds0 = (unsigned)(size_t)lds;
    const int rot = (int)(blockIdx.x & 7) * 4;
    pg8::Unit cur, nxt; int ui = 0;
    if (!S.next(0, cur)) return;
    f32x4 acc[2][2][4][2];
#pragma unroll
    for (int a = 0; a < 2; ++a)
#pragma unroll
        for (int b = 0; b < 2; ++b)
#pragma unroll
            for (int m = 0; m < 4; ++m)
#pragma unroll
                for (int n = 0; n < 2; ++n) acc[a][b][m][n] = (f32x4){0.f, 0.f, 0.f, 0.f};
    u32x2 sb[8], pk[8];
    unsigned ao[4], bo, tk[4]; __amdgpu_buffer_rsrc_t wrs_;
    const int* tokp = G1 ? tok : (const int*)A;
#define RG_SETUP(un) do { int l2 = lane; asm volatile("" : "+v"(l2)); _Pragma("unroll") for (int i = 0; i < 4; ++i) { const int R_ = 128 * wr + 8 * (wid & 3) + 32 * i + (l2 >> 3), C_ = ((l2 & 7) ^ ((R_ >> 1) & 7)) * 8; const int rr = (un).pm * 256 + R_; \
        ao[i] = ((unsigned)(G1 ? tok[rr] : rr) * (unsigned)K + (unsigned)C_) * 2u; } \
        const int c4 = 4 * l2; const int col = G1 ? ((c4 < 128) ? (un).pn * 128 + c4 : 2048 + (un).pn * 128 + (c4 - 128)) : (un).pn * 256 + c4; \
        bo = (unsigned)col * 4u; wrs_ = __builtin_amdgcn_make_buffer_rsrc((void*)(W + (size_t)(un).e * K * N), 0, K * N * 4, 0x00077FAC); } while (0)
#define RG_SETUP_PF(un) do { int l2 = lane; asm volatile("" : "+v"(l2)); _Pragma("unroll") for (int i = 0; i < 4; ++i) { const int R_ = 128 * wr + 8 * (wid & 3) + 32 * i + (l2 >> 3), C_ = ((l2 & 7) ^ ((R_ >> 1) & 7)) * 8; const int rr = (un).pm * 256 + R_; \
        ao[i] = ((unsigned)(G1 ? (int)tk[i] : rr) * (unsigned)K + (unsigned)C_) * 2u; } \
        const int c4 = 4 * l2; const int col = G1 ? ((c4 < 128) ? (un).pn * 128 + c4 : 2048 + (un).pn * 128 + (c4 - 128)) : (un).pn * 256 + c4; \
        bo = (unsigned)col * 4u; wrs_ = __builtin_amdgcn_make_buffer_rsrc((void*)(W + (size_t)(un).e * K * N), 0, K * N * 4, 0x00077FAC); } while (0)
#define RG_TOK_PF(un) do { int l2 = lane; asm volatile("" : "+v"(l2)); const unsigned of0_ = (unsigned)(((un).pm * 256 + 128 * wr + 8 * (wid & 3) + (l2 >> 3)) * 4); \
        asm volatile("global_load_dword %0, %4, %5\n\tglobal_load_dword %1, %4, %5 offset:128\n\tglobal_load_dword %2, %4, %5 offset:256\n\tglobal_load_dword %3, %4, %5 offset:384" \
                     : "=&v"(tk[0]), "=&v"(tk[1]), "=&v"(tk[2]), "=&v"(tk[3]) : "v"(of0_), "s"(tokp) : "memory"); } while (0)
#define RG_ISSUE_A(buf, kt) do { const char* ab_ = (const char*)A + (size_t)((ABL & 16) ? 0 : (((kt) + rot) & (nt - 1))) * 128; unsigned keep_; \
        const unsigned d0_ = (unsigned)__builtin_amdgcn_readfirstlane((int)(lds0 + (unsigned)((buf) * A_BUF + (128 * wr + 8 * (wid & 3)) * 128)));     \
        asm volatile("s_mov_b32 %0, m0\n\ts_mov_b32 m0, %5\n\ts_nop 0\n\tglobal_load_lds_dwordx4 %1, %6\n\ts_add_u32 m0, m0, 0x1000\n\ts_nop 0\n\tglobal_load_lds_dwordx4 %2, %6\n\t" \
                     "s_add_u32 m0, m0, 0x1000\n\ts_nop 0\n\tglobal_load_lds_dwordx4 %3, %6\n\ts_add_u32 m0, m0, 0x1000\n\ts_nop 0\n\tglobal_load_lds_dwordx4 %4, %6\n\ts_mov_b32 m0, %0" \
                     : "=&s"(keep_) : "v"(ao[0]), "v"(ao[1]), "v"(ao[2]), "v"(ao[3]), "s"(d0_), "s"(ab_) : "memory", "scc"); } while (0)
#define RG_ISSUE_B_TO(kt, DST) do { const unsigned r0_ = (unsigned)(((((kt) + rot) & (nt - 1)) * 64 + 8 * wid) * N) * 4u; const unsigned rs_ = (unsigned)N * 4u; \
        asm volatile("s_nop 4\n\tbuffer_load_format_d16_xyzw %0, %8, %9, %10 offen\n\tbuffer_load_format_d16_xyzw %1, %8, %9, %11 offen\n\tbuffer_load_format_d16_xyzw %2, %8, %9, %12 offen\n\tbuffer_load_format_d16_xyzw %3, %8, %9, %13 offen\n\t" \
                     "buffer_load_format_d16_xyzw %4, %8, %9, %14 offen\n\tbuffer_load_format_d16_xyzw %5, %8, %9, %15 offen\n\tbuffer_load_format_d16_xyzw %6, %8, %9, %16 offen\n\tbuffer_load_format_d16_xyzw %7, %8, %9, %17 offen" \
                     : "=&v"(DST[0]), "=&v"(DST[1]), "=&v"(DST[2]), "=&v"(DST[3]), "=&v"(DST[4]), "=&v"(DST[5]), "=&v"(DST[6]), "=&v"(DST[7]) \
                     : "v"(bo), "s"(wrs_), "s"(r0_), "s"(r0_ + rs_), "s"(r0_ + 2u * rs_), "s"(r0_ + 3u * rs_), "s"(r0_ + 4u * rs_), "s"(r0_ + 5u * rs_), "s"(r0_ + 6u * rs_), "s"(r0_ + 7u * rs_) : "memory"); } while (0)
#define RG_ISSUE_B(kt) RG_ISSUE_B_TO(kt, sb)
#define RG_WAIT_B() asm volatile("s_waitcnt vmcnt(4)" : "+v"(sb[0]), "+v"(sb[1]), "+v"(sb[2]), "+v"(sb[3]), "+v"(sb[4]), "+v"(sb[5]), "+v"(sb[6]), "+v"(sb[7]) :: "memory")
#define RG_CVT_B() do { _Pragma("unroll") for (int j = 0; j < 8; ++j) asm volatile("v_and_b32 %0, 0xfff8fff8, %2\n\tv_and_b32 %1, 0xfff8fff8, %3" : "=&v"(pk[j].x), "=&v"(pk[j].y) : "v"(sb[j].x), "v"(sb[j].y)); } while (0)
#define RG_STORE_B(buf) do { _Pragma("unroll") for (int j = 0; j < 8; ++j) *(LAS u32x2*)(lds + B_OFF + (buf) * B_BUF + (bwr ^ bsw) + j * BROW) = pk[j];     } while (0)
#define RG_LDA(dst, buf, ks, ai) do { _Pragma("unroll") for (int m = 0; m < 4; ++m) dst[m] = *(const LAS bf16x8*)(lds + (buf) * A_BUF + (ard ^ (unsigned)((ks) * 64)) + (ai) * 8192 + m * 2048); } while (0)
#define RG_LDB(dst, buf, ks) do { _Pragma("unroll") for (int bj = 0; bj < 2; ++bj) _Pragma("unroll") for (int n = 0; n < 2; ++n) { const LAS unsigned char* bp = lds + B_OFF + (buf) * B_BUF + (ks) * 32 * BROW + (brd ^ (unsigned)(n * 8)) + bj * 256; \
            const s16x4 t1 = ds_tr16(bp), t2 = ds_tr16(bp + 4 * BROW); dst[bj][n] = __builtin_shufflevector(t1, t2, 0, 1, 2, 3, 4, 5, 6, 7); } } while (0)
#define RG_MMA(ai, Af, Bf) do { _Pragma("unroll") for (int m = 0; m < 4; ++m) _Pragma("unroll") for (int bj = 0; bj < 2; ++bj) _Pragma("unroll") for (int n = 0; n < 2; ++n) \
            acc[ai][bj][m][n] = __builtin_amdgcn_mfma_f32_16x16x32_f16(__builtin_bit_cast(h16x8, Bf[bj][n]), __builtin_bit_cast(h16x8, Af[m]), acc[ai][bj][m][n], 0, 0, 0); } while (0)
#define RG_COMPUTE_HEAD(buf) do { \
        RG_LDB(Be, buf, 0); RG_LDA(Ae, buf, 0, 0); RG_LDA(Ao, buf, 0, 1); __builtin_amdgcn_sched_barrier(0); \
        RG_MMA(0, Ae, Be); __builtin_amdgcn_sched_barrier(0); \
        RG_LDB(Bo, buf, 1); RG_LDA(Ae, buf, 1, 0); __builtin_amdgcn_sched_barrier(0); \
        RG_MMA(1, Ao, Be); __builtin_amdgcn_sched_barrier(0); \
        RG_LDA(Ao, buf, 1, 1); __builtin_amdgcn_sched_barrier(0); \
        RG_MMA(0, Ae, Bo); __builtin_amdgcn_sched_barrier(0); } while (0)
#define RG_COMPUTE_TAIL() do { __builtin_amdgcn_sched_barrier(0); RG_MMA(1, Ao, Bo); __builtin_amdgcn_sched_barrier(0); } while (0)
#define RG_BAR() do { asm volatile("s_waitcnt lgkmcnt(0)" ::: "memory"); __builtin_amdgcn_s_barrier(); asm volatile("" ::: "memory"); } while (0)
#define RG_VM0() asm volatile("s_waitcnt vmcnt(0)" ::: "memory")
#define RG_ISSUE_EPI(un, slot) do { if (wid == 0) { int l3 = lane; asm volatile("" : "+v"(l3)); _Pragma("unroll") for (int pc = 0; pc < Epi::NDMA; ++pc) { unsigned keep_; const unsigned dst_ = (unsigned)__builtin_amdgcn_readfirstlane((int)(lds0 + (unsigned)(EPI_OFF + (slot) * EPI_SLOT + pc * 1024))); \
            asm volatile("s_mov_b32 %0, m0\n\ts_mov_b32 m0, %2\n\ts_nop 0\n\tglobal_load_lds_dwordx4 %1, %3\n\ts_mov_b32 m0, %0" : "=&s"(keep_) : "v"(E.dma_off(pc, l3)), "s"(dst_), "s"(E.dma_base(un, pc)) : "memory"); } } } while (0)
    RG_SETUP(cur);
    if (ABL == 0) RG_ISSUE_EPI(cur, 0);
    if (ABL & 2) { _Pragma("unroll") for (int j = 0; j < 8; ++j) { sb[j] = (u32x2){0u, 0u}; asm volatile("" : "+v"(sb[j])); } }
    if (ABL & 8) { _Pragma("unroll") for (int j = 0; j < 8; ++j) { pk[j] = (u32x2){0u, 0u}; asm volatile("" : "+v"(pk[j])); } }
    RG_ISSUE_A(0, 0); RG_ISSUE_B_TO(0, pk); RG_ISSUE_B_TO(1, sb);
    asm volatile("s_waitcnt vmcnt(0)" : "+v"(pk[0]), "+v"(pk[1]), "+v"(pk[2]), "+v"(pk[3]), "+v"(pk[4]), "+v"(pk[5]), "+v"(pk[6]), "+v"(pk[7]), "+v"(sb[0]), "+v"(sb[1]), "+v"(sb[2]), "+v"(sb[3]), "+v"(sb[4]), "+v"(sb[5]), "+v"(sb[6]), "+v"(sb[7]) :: "memory");
#pragma unroll
    for (int j = 0; j < 8; ++j) asm volatile("v_and_b32 %0, 0xfff8fff8, %0\n\tv_and_b32 %1, 0xfff8fff8, %1" : "+v"(pk[j].x), "+v"(pk[j].y));
    RG_STORE_B(0); RG_BAR();
    if (wr == 1) __builtin_amdgcn_s_barrier();
    int ntv = nt; asm volatile("" : "+s"(ntv));
    for (;;) {
        const bool has_next = S.next(ui + 1, nxt);
#pragma unroll 1
        for (int t = 0; t < ntv; ++t) {
            const int cb = t & 1;
            const bool last2 = (t + 2 >= ntv), last1 = (t + 1 >= ntv);
            const bool nexta = !last1 || has_next;
            const bool sw = last2 && !last1 && has_next;
            if (G1 && sw) RG_TOK_PF(nxt);
            if (nexta) { if (!(ABL & 4)) RG_ISSUE_A(cb ^ 1, (t + 1) & (nt - 1)); if (!(ABL & 2)) RG_WAIT_B(); if (!(ABL & 8)) RG_CVT_B(); } else RG_VM0();
            if (sw) { if (G1) asm volatile("" : "+v"(tk[0]), "+v"(tk[1]), "+v"(tk[2]), "+v"(tk[3])); RG_SETUP_PF(nxt); }
            if (!(ABL & 2)) if (!last2 || (has_next && !last1)) RG_ISSUE_B((t + 2) & (nt - 1));
            RG_BAR();
            if (nexta && !(ABL & 8)) RG_STORE_B(cb ^ 1);
            bf16x8 Ae[4], Ao[4], Be[2][2], Bo[2][2];
            if (!(ABL & 1)) RG_COMPUTE_HEAD(cb);
            RG_BAR();
            if (!(ABL & 1)) RG_COMPUTE_TAIL();
        }
        if (has_next && ABL == 0) { RG_ISSUE_B(1); RG_ISSUE_EPI(nxt, (ui + 1) & 1); }
        if (ABL == 0) E(acc, cur, wr, wc, fr, fq, (const LAS float*)(lds + EPI_OFF + (ui & 1) * EPI_SLOT));
        else { _Pragma("unroll") for (int a = 0; a < 2; ++a) _Pragma("unroll") for (int b = 0; b < 2; ++b) _Pragma("unroll") for (int m = 0; m < 4; ++m) asm volatile("" :: "v"(acc[a][b][m][0]), "v"(acc[a][b][m][1])); }
        if (!has_next) break;
        if (ABL != 0 && !(ABL & 2)) RG_ISSUE_B(1);
#pragma unroll
        for (int a = 0; a < 2; ++a)
#pragma unroll
            for (int b = 0; b < 2; ++b)
#pragma unroll
                for (int m = 0; m < 4; ++m)
#pragma unroll
                    for (int n = 0; n < 2; ++n) acc[a][b][m][n] = (f32x4){0.f, 0.f, 0.f, 0.f};
        cur = nxt; ++ui;
    }
    if (wr == 0) __builtin_amdgcn_s_barrier();
    RG_BAR();
#undef RG_SETUP
#undef RG_ISSUE_A
#undef RG_ISSUE_B
#undef RG_ISSUE_B_TO
#undef RG_WAIT_B
#undef RG_CVT_B
#undef RG_STORE_B
#undef RG_COMPUTE_HEAD
#undef RG_COMPUTE_TAIL
#undef RG_LDA
#undef RG_LDB
#undef RG_MMA
#undef RG_BAR
#undef RG_VM0
#undef RG_SETUP_PF
#undef RG_TOK_PF
#undef RG_ISSUE_EPI
}
}

#define XB_TMO      128
#define XB_XCNT(j)  (256  + 64 * (j))
#define XB_XSUB(j)  (1280 + 64 * (j))
#define XB_XGEN(j)  (2304 + 64 * (j))
#define XB_TOP      3328
#define XB_TOPGEN   3392
#define XCD_BAR_WORDS 3456
#define XB_SPIN_CAP (1u << 18)
__device__ __forceinline__ unsigned xb_ld(unsigned* p)              { return __hip_atomic_load(p, __ATOMIC_RELAXED, __HIP_MEMORY_SCOPE_AGENT); }
__device__ __forceinline__ unsigned xb_add(unsigned* p, unsigned v) { return __hip_atomic_fetch_add(p, v, __ATOMIC_RELAXED, __HIP_MEMORY_SCOPE_AGENT); }
__device__ __forceinline__ unsigned xb_xcc_id() { return (unsigned)__builtin_amdgcn_s_getreg((3 << 11) | 20) & 0xFu; }
#define XB_SPIN(cond, bar) do { unsigned _sp = 0; while (cond) { __builtin_amdgcn_s_sleep(1); \
    if ((++_sp & 255u) == 0u) { if (xb_ld(&(bar)[XB_TMO])) break; if (_sp > XB_SPIN_CAP) { atomicAdd(&(bar)[XB_TMO], 1u); break; } } } } while (0)
struct XcdBarrier { unsigned* bar; unsigned x; volatile LAS unsigned* st; };
__device__ __forceinline__ XcdBarrier xcd_barrier_post(unsigned* bar, volatile LAS unsigned* st) {
    XcdBarrier b; b.bar = bar; b.x = xb_xcc_id(); b.st = st;
    if (threadIdx.x == 0) (void)xb_add(&bar[XB_XCNT(b.x)], 1u);
    return b;
}
__device__ __forceinline__ void xcd_barrier_complete(unsigned* bar, unsigned x, unsigned& nloc, unsigned& nx) {
    const unsigned G = gridDim.x * gridDim.y * gridDim.z;
    unsigned sum, cnt, mine, sp = 0u;
    for (;;) {
        sum = 0u; cnt = 0u; mine = 0u;
#pragma unroll
        for (unsigned j = 0; j < 16; ++j) { const unsigned c = xb_ld(&bar[XB_XCNT(j)]); sum += c; cnt += (c > 0u) ? 1u : 0u; mine = (j == x) ? c : mine; }
        if (sum == G) break;
        __builtin_amdgcn_s_sleep(1);
        if ((++sp & 255u) == 0u) { if (xb_ld(&bar[XB_TMO])) break; if (sp > XB_SPIN_CAP) { atomicAdd(&bar[XB_TMO], 1u); break; } }
    }
    nloc = mine > 0u ? mine : 1u; nx = cnt > 0u ? cnt : 1u;
}
__device__ __forceinline__ void xcd_barrier(const XcdBarrier& b) {
    asm volatile("s_waitcnt vmcnt(0)" ::: "memory");
    __syncthreads();
    if (threadIdx.x == 0) {
        unsigned* bar = b.bar;
        __builtin_amdgcn_s_waitcnt(0);
        unsigned nloc = b.st[0], nx = b.st[1];
        if (nloc == 0u) { xcd_barrier_complete(bar, b.x, nloc, nx); b.st[0] = nloc; b.st[1] = nx; }
        const unsigned old = xb_add(&bar[XB_XSUB(b.x)], 1u);
        const unsigned gen = old / nloc;
        if (old + 1u == (gen + 1u) * nloc) {
            __builtin_amdgcn_fence(__ATOMIC_RELEASE, "agent");
            asm volatile("s_waitcnt vmcnt(0)" ::: "memory");
            const unsigned og = xb_add(&bar[XB_TOP], 1u);
            const unsigned tg = og / nx;
            if (og + 1u == (tg + 1u) * nx) xb_add(&bar[XB_TOPGEN], 1u);
            else XB_SPIN(xb_ld(&bar[XB_TOPGEN]) == tg, bar);
            __builtin_amdgcn_fence(__ATOMIC_ACQUIRE, "agent");
            xb_add(&bar[XB_XGEN(b.x)], 1u);
            asm volatile("s_waitcnt vmcnt(0)" ::: "memory");
        } else {
            XB_SPIN(xb_ld(&bar[XB_XGEN(b.x)]) == gen, bar);
            __builtin_amdgcn_fence(__ATOMIC_ACQUIRE, "agent");
            asm volatile("s_waitcnt vmcnt(0)" ::: "memory");
        }
    }
    __syncthreads();
}

constexpr int NPH = 11;
struct Args { const float* in[20]; float* out; unsigned char* ws; int ph_lo, ph_hi, li, pad; };

__device__ __forceinline__ void transpose_item(const float* W, int K, int N, bf16_t* WT, int k0, int n0, int drow, LAS float* scr, int lane) {
#pragma unroll 8
    for (int i = 0; i < 32; ++i) { const int kk = 2 * i + (lane >> 5); scr[kk * 33 + (lane & 31)] = W[(size_t)(k0 + kk) * N + n0 + (lane & 31)]; }
    LDS_WAIT(); asm volatile("" ::: "memory");
    const int c = lane & 7;
#pragma unroll
    for (int j = 0; j < 4; ++j) { const int n = (lane >> 3) + 8 * j; const LAS float* s = scr + (8 * c) * 33 + n;
        u32x4 o; o.x = pk2(s[0 * 33], s[1 * 33]); o.y = pk2(s[2 * 33], s[3 * 33]); o.z = pk2(s[4 * 33], s[5 * 33]); o.w = pk2(s[6 * 33], s[7 * 33]);
        *(GAS u32x4*)(WT + (size_t)(drow + n) * K + k0 + 8 * c) = o; }
    LDS_WAIT(); asm volatile("" ::: "memory");
}

__global__ void __launch_bounds__(NTHR, 2) fwd_kernel(Args args) {
    extern __shared__ __attribute__((aligned(16))) unsigned char lds_raw[];
    LAS unsigned char* lds = (LAS unsigned char*)lds_raw;
    volatile LAS unsigned* MISC = (volatile LAS unsigned*)(lds + MISC_OFF);
    const int tid = threadIdx.x, lane = tid & 63, wave = __builtin_amdgcn_readfirstlane(tid >> 6);
    const int G = gridDim.x, bx = blockIdx.x;
    unsigned char* ws = args.ws;
    gu32* ctl = (gu32*)(ws + WS_CTL);
    const float* x = args.in[0]; const float* cvec = args.in[1]; const float* w_ada = args.in[2]; const float* b_ada = args.in[3]; const float* w_in = args.in[4];
    const float* sgu_g = args.in[5]; const float* sgu_b = args.in[6]; const float* w_sp = args.in[7]; const float* b_sp = args.in[8]; const float* w_o = args.in[9];
    const float* ln1_g = args.in[10]; const float* ln1_b = args.in[11]; const float* w_router = args.in[12]; const float* b_router = args.in[13];
    const float* w_e1 = args.in[14]; const float* b_e1 = args.in[15]; const float* w_e2 = args.in[16]; const float* b_e2 = args.in[17]; const float* ln2_g = args.in[18]; const float* ln2_b = args.in[19];
    float* out = args.out;
    float* PADA = (float*)(ws + WS_PADA);
    float* WRT = (float*)(ws + WS_PADA + MiB + 512 * 1024);
    float* ADA = (float*)(ws + WS_PADA + MiB);
    bf16_t* WINT = (bf16_t*)(ws + WS_WIN); bf16_t* WOT = (bf16_t*)(ws + WS_WO);
    bf16_t* H = (bf16_t*)(ws + WS_H); bf16_t* PROJ = (bf16_t*)(ws + WS_PROJ); bf16_t* OB = (bf16_t*)(ws + WS_OB); bf16_t* Y = (bf16_t*)(ws + WS_Y);
    bf16_t* Z = (bf16_t*)(ws + WS_Z); bf16_t* X1 = (bf16_t*)(ws + WS_X1);   bf16_t* H2 = (bf16_t*)(ws + WS_H2); bf16_t* ACT = (bf16_t*)(ws + WS_ACT); bf16_t* CONTRIB = (bf16_t*)(ws + WS_CONTRIB);
    int* TOPI = (int*)(ws + WS_SMALL + SM_TOPI); float* TOPG = (float*)(ws + WS_SMALL + SM_TOPG); int* RBC = (int*)(ws + WS_SMALL + SM_RBC);
    int* TOK = (int*)(ws + WS_SMALL + SM_TOK); float* GATEP = (float*)(ws + WS_SMALL + SM_GATEP); int* POSOF = (int*)(ws + WS_SMALL + SM_POSOF);
    int* TEXP = (int*)(ws + WS_SMALL + SM_TEXP);
    float* LSE = (float*)(ws + WS_SMALL + SM_LSE);

    for (int u = tid; u < (LDS_BYTES - MISC_OFF) / 4; u += NTHR) ((LAS unsigned*)(lds + MISC_OFF))[u] = 0u;
    __syncthreads();
    constexpr bool ONE = (MK_N_LAUNCHES == 1);
    XcdBarrier bar; bar.bar = (unsigned*)(ctl + CW_BAR); bar.x = 0; bar.st = nullptr;
    if (ONE) bar = xcd_barrier_post((unsigned*)(ctl + CW_BAR), MISC + 8);
#define GRID_BAR() do { if (ONE) xcd_barrier(bar); } while (0)
    const int lo = args.ph_lo, hi = args.ph_hi;
#ifndef MK_PH_MASK
#define MK_PH_MASK 0x7ff
#endif
#define IN(k) ((((MK_PH_MASK) >> (k)) & 1) && lo <= (k) && (k) < hi)
#define BOTH(k) (IN(k) && IN((k) + 1))
    const int gtid = bx * NTHR + tid, GT = G * NTHR, gw = bx * NWAVES + wave, NGW = G * NWAVES;

    if (IN(0)) { for (int rep = 0; rep < NREP(0); ++rep) {
        LAS float* red = (LAS float*)lds;
#define ADA_ITEM(ks_, ns_) do { const int col_ = (ns_) * 256 + lane * 4; f32x4 a_ = (f32x4){0.f, 0.f, 0.f, 0.f}; \
            _Pragma("unroll 4") for (int r = 0; r < 16; ++r) { const int k = (ks_) * 128 + wave * 16 + r; const float cv = cvec[k]; const float sv = cv / (1.0f + __expf(-cv)); \
                a_ += *(const f32x4*)(w_ada + (size_t)k * (6 * D) + col_) * sv; } \
            _Pragma("unroll") for (int j = 0; j < 4; ++j) red[wave * 256 + lane * 4 + j] = a_[j]; \
            __syncthreads(); \
            if (tid < 256) { float s_ = 0.f; _Pragma("unroll") for (int w = 0; w < 8; ++w) s_ += red[w * 256 + tid]; PADA[(ks_) * (6 * D) + (ns_) * 256 + tid] = s_; } \
            __syncthreads(); } while (0)
        for (int it = bx; it < 16 * 16 && rep == 0; it += G) ADA_ITEM(it / 16, it % 16);
        LAS float* scr = (LAS float*)(lds + wave * 16384);
        constexpr int I_IN = 32 * (NPROJ / 32);
        for (int it = gw; it < I_IN; it += NGW) { const int nblk = NPROJ / 32, kb = it / nblk, nb = it % nblk; transpose_item(w_in, D, NPROJ, WINT, 64 * kb, 32 * nb, 32 * nb, scr, lane); }
        if (BOTH(0) || rep + 1 < NREP(0)) GRID_BAR();
    } }

    if (IN(1)) { for (int rep = 0; rep < NREP(1); ++rep) {
        LAS float* ssl = (LAS float*)lds;
        for (int j = tid; j < 2 * D; j += NTHR) { float s = b_ada[j];
#pragma unroll
            for (int q = 0; q < 16; ++q) s += PADA[q * (6 * D) + j];
            ssl[j] = s; }
        __syncthreads();
        { const int col = (gtid % (D / 4)) * 4;
          const f32x4 sh = *(const LAS f32x4*)(ssl + col), sc1 = *(const LAS f32x4*)(ssl + D + col) + 1.0f;
          for (int i0 = gtid; i0 < S * (D / 4); i0 += 8 * GT) {
              f32x4 xv[8];
#pragma unroll
              for (int u = 0; u < 8; ++u) { const int i = i0 + u * GT; xv[u] = (i < S * (D / 4)) ? *(const f32x4*)(x + (size_t)i * 4) : (f32x4){0.f, 0.f, 0.f, 0.f}; }
#pragma unroll
              for (int u = 0; u < 8; ++u) { const int i = i0 + u * GT; const f32x4 hv = xv[u] * sc1 + sh;
                  u32x2 w; w.x = pk2(hv[0], hv[1]); w.y = pk2(hv[2], hv[3]);
                  if (i < S * (D / 4)) *(u32x2*)(H + (size_t)i * 4) = w; }
          } }
        __syncthreads();
        if (BOTH(1) || rep + 1 < NREP(1)) GRID_BAR();
    } }

    if (IN(2)) { for (int rep = 0; rep < NREP(2); ++rep) {
        pg8::Gemm g{H, WINT, D}; pg8::EpiProj E{PROJ};
        constexpr int NU = (S / 256) * (NPROJ / 256);
        pg8::DenseOrder So{S / 256, NPROJ / 256, G, bx, NU};
        pg8::gemm_phase<pg8::EpiProj, pg8::DenseOrder, false>(lds, g, So, E, nullptr);
        if (rep == 0) {
            const int first = NU % G, nidle = G - first, w = bx - first;
            if (w >= 0) {
                LAS float* red = (LAS float*)lds;
                for (int it = w; it < 16 * 32; it += nidle) ADA_ITEM(it / 32, 16 + it % 32);
                constexpr int I_O = 32 * (D / 32), I_TOK = CAP / 1024, I_WRT = NE * D / 1024, NFILL = I_O + I_TOK + I_WRT + 1;
                LAS float* scr = (LAS float*)(lds + wave * 16384);
                for (int it0 = w * 8 + wave; it0 < NFILL; it0 += nidle * 8) { int it = it0;
                    if (it < I_O) { const int nblk = D / 32, kb = it / nblk, nb = it % nblk; transpose_item(w_o, D, D, WOT, 64 * kb, 32 * nb, 32 * nb, scr, lane); continue; }
                    it -= I_O;
                    if (it < I_TOK) { for (int i = it * 1024 + lane; i < it * 1024 + 1024; i += 64) { TOK[i] = S; GATEP[i] = 0.f; } continue; }
                    it -= I_TOK;
                    if (it < I_WRT) { for (int i = it * 1024 + lane; i < it * 1024 + 1024; i += 64) WRT[i] = w_router[(size_t)(i & (D - 1)) * NE + (i >> 11)]; continue; }
                    for (int i = lane; i < D / 2; i += 64) ((unsigned*)(H2 + (size_t)S * D))[i] = 0u;
                }
            }
        }
#undef ADA_ITEM
        if (BOTH(2) || rep + 1 < NREP(2)) GRID_BAR();
    } }

    if (IN(3)) { for (int rep = 0; rep < NREP(3); ++rep) {
        for (int j = 2 * D + gtid; j < 6 * D; j += GT) { float s = b_ada[j];
#pragma unroll
            for (int q = 0; q < 16; ++q) s += PADA[q * (6 * D) + j];
            ADA[j] = s; }
        const int fr = lane & 15, fq = lane >> 4;
        const int vcu = (G % 8 == 0) ? (bx % 8) * (G / 8) + bx / 8 : bx;
        for (int uu = vcu; uu < 2048; uu += G) {
            if (uu >= 1536) {
                const int q = uu - 1536, n = q >> 3, g = q & 7;
                LAS unsigned char* vh = lds;
                unsigned pkv[16];
#pragma unroll
                for (int rr = 0; rr < 16; ++rr) pkv[rr] = *(const unsigned*)(PROJ + (size_t)(n * 128 + wave * 16 + rr) * NPROJ + DG + g * 128 + 2 * lane);
#pragma unroll
                for (int rr = 0; rr < 16; ++rr) {
                    const int s = wave * 16 + rr;
                    const unsigned pk = pkv[rr];
                    const float a = bflo(pk), b = bfhi(pk);
                    const float mean = wave_sum(a + b) * (1.0f / 128.0f);
                    const float da = a - mean, db = b - mean;
                    const float var = wave_sum(da * da + db * db) * (1.0f / 128.0f);
                    const float rstd = __builtin_amdgcn_rsqf(var + LN_EPS);
                    const int c = g * 128 + 2 * lane;
                    *(LAS unsigned*)(vh + s * 288 + lane * 4) = pk2(da * rstd * sgu_g[c] + sgu_b[c], db * rstd * sgu_g[c + 1] + sgu_b[c + 1]);
                }
                __syncthreads();
                const int t = wave * 16 + fr;
                const float* wrow = w_sp + ((size_t)g * 128 + t) * 128;
                f32x4 acc[8];
#pragma unroll
                for (int ct = 0; ct < 8; ++ct) acc[ct] = (f32x4){0.f, 0.f, 0.f, 0.f};
                const int nks = (wave >> 1) + 1;
                f32x4 w0v[4], w1v[4];
#pragma unroll
                for (int ks = 0; ks < 4; ++ks) { w0v[ks] = *(const f32x4*)(wrow + 32 * ks + 4 * fq); w1v[ks] = *(const f32x4*)(wrow + 32 * ks + 4 * fq + 16); }
                const float bias = b_sp[g * 128 + t];
                u32x2 ug[8];
#pragma unroll
                for (int ct = 0; ct < 8; ++ct) ug[ct] = *(const u32x2*)(PROJ + (size_t)(n * 128 + t) * NPROJ + g * 128 + 16 * ct + 4 * fq);
#pragma unroll
                for (int ks = 0; ks < 4; ++ks) { if (ks >= nks) break;
                    const int s0 = 32 * ks + 4 * fq, s1 = s0 + 16;
                    f32x4 w0 = w0v[ks], w1 = w1v[ks];
#pragma unroll
                    for (int j = 0; j < 4; ++j) { if (s0 + j > t) w0[j] = 0.f; if (s1 + j > t) w1[j] = 0.f; }
                    u32x4 wb; wb.x = pg8::cvt_pk_bf16(w0[0], w0[1]); wb.y = pg8::cvt_pk_bf16(w0[2], w0[3]); wb.z = pg8::cvt_pk_bf16(w1[0], w1[1]); wb.w = pg8::cvt_pk_bf16(w1[2], w1[3]);
                    const bf16x8 bfrag = __builtin_bit_cast(bf16x8, wb);
                    const LAS unsigned char* vb = vh + (32 * ks + 4 * fq + (fr >> 2)) * 288 + (fr & 3) * 8;
                    bf16x8 vfr[8];
#pragma unroll
                    for (int ct = 0; ct < 8; ++ct) { const s16x4 t1 = ds_tr16(vb + ct * 32), t2 = ds_tr16(vb + ct * 32 + 16 * 288); vfr[ct] = __builtin_bit_cast(bf16x8, __builtin_shufflevector(t1, t2, 0, 1, 2, 3, 4, 5, 6, 7)); }
                    asm volatile("" : "+v"(vfr[0]), "+v"(vfr[1]), "+v"(vfr[2]), "+v"(vfr[3]), "+v"(vfr[4]), "+v"(vfr[5]), "+v"(vfr[6]), "+v"(vfr[7]));
#pragma unroll
                    for (int ct = 0; ct < 8; ++ct) acc[ct] = __builtin_amdgcn_mfma_f32_16x16x32_bf16(vfr[ct], bfrag, acc[ct], 0, 0, 0);
                }
                { const size_t row = (size_t)(n * 128 + t);
#pragma unroll
                  for (int ct = 0; ct < 8; ++ct) { const int c = g * 128 + 16 * ct + 4 * fq;
                      const u32x2 uu2 = ug[ct];
                      u32x2 o; o.x = pk2(bflo(uu2.x) * (acc[ct][0] + bias), bfhi(uu2.x) * (acc[ct][1] + bias)); o.y = pk2(bflo(uu2.y) * (acc[ct][2] + bias), bfhi(uu2.y) * (acc[ct][3] + bias));
                      *(u32x2*)(Y + row * D + c) = o; } }
                __syncthreads();
            } else {
                const int b = uu >> 9, rem = uu & 511, h = rem >> 6, idx = rem & 63;
                const int dil = b == 0 ? 1 : (b == 1 ? 4 : 16), nb = 64 / dil, r = idx / nb, n = idx % nb;
                LAS unsigned char* Ks = lds;
                LAS unsigned char* Vs = lds + 65536;
                const int i = wave * 16 + fr; const size_t qpos = (size_t)(n * 128 + i) * dil + r;
                bf16x8 qf[4];
#pragma unroll
                for (int ks = 0; ks < 4; ++ks) qf[ks] = *(const bf16x8*)(PROJ + qpos * NPROJ + 2048 + h * 128 + 32 * ks + 8 * fq);
                { u32x4 kq[8], vq[8];
#pragma unroll
                  for (int j = 0; j < 8; ++j) { const int id = tid + NTHR * j, key = id >> 4, ch = id & 15, kj = (n - 1) * 128 + key;
                      const size_t pos = (size_t)(kj >= 0 ? kj : kj + 128) * dil + r; const bf16_t* pr = PROJ + pos * NPROJ + h * 128 + ch * 8;
                      kq[j] = *(const u32x4*)(pr + 3072); vq[j] = *(const u32x4*)(pr + 4096); }
                  asm volatile("" : "+v"(kq[0]), "+v"(kq[1]), "+v"(kq[2]), "+v"(kq[3]), "+v"(kq[4]), "+v"(kq[5]), "+v"(kq[6]), "+v"(kq[7]), "+v"(vq[0]), "+v"(vq[1]), "+v"(vq[2]), "+v"(vq[3]), "+v"(vq[4]), "+v"(vq[5]), "+v"(vq[6]), "+v"(vq[7]));
#pragma unroll
                  for (int j = 0; j < 8; ++j) { const int id = tid + NTHR * j, key = id >> 4, ch = id & 15, kj = (n - 1) * 128 + key;
                      u32x4 kv = kq[j], vv = vq[j];
                      if (kj < 0) { kv = (u32x4){0u, 0u, 0u, 0u}; vv = (u32x4){0u, 0u, 0u, 0u}; }
                      *(LAS u32x4*)(Ks + key * 256 + ((ch ^ (key & 15)) << 4)) = kv; *(LAS u32x4*)(Vs + key * 288 + ch * 16) = vv; } }
                __syncthreads();
                const int T0 = wave & ~1;
                f32x4 sa[10];
#pragma unroll
                for (int t = 0; t < 10; ++t) sa[t] = (f32x4){0.f, 0.f, 0.f, 0.f};
                { bf16x8 kf[2][2][4];
#define ATT_LDK(buf, grp) do { _Pragma("unroll") for (int tt = 0; tt < 2; ++tt) _Pragma("unroll") for (int ks = 0; ks < 4; ++ks) \
                        kf[buf][tt][ks] = *(const LAS bf16x8*)(Ks + (16 * (T0 + 2 * (grp) + tt) + fr) * 256 + (((4 * ks + fq) ^ fr) << 4)); } while (0)
                  ATT_LDK(0, 0);
#pragma unroll
                  for (int grp = 0; grp < 5; ++grp) {
                      if (grp + 1 < 5) ATT_LDK((grp + 1) & 1, grp + 1);
                      asm volatile("" : "+v"(kf[grp & 1][0][0]), "+v"(kf[grp & 1][0][1]), "+v"(kf[grp & 1][0][2]), "+v"(kf[grp & 1][0][3]), "+v"(kf[grp & 1][1][0]), "+v"(kf[grp & 1][1][1]), "+v"(kf[grp & 1][1][2]), "+v"(kf[grp & 1][1][3]));
#pragma unroll
                      for (int ks = 0; ks < 4; ++ks)
#pragma unroll
                          for (int tt = 0; tt < 2; ++tt) sa[2 * grp + tt] = __builtin_amdgcn_mfma_f32_16x16x32_bf16(kf[grp & 1][tt][ks], qf[ks], sa[2 * grp + tt], 0, 0, 0);
                  }
#undef ATT_LDK
                }
                const float slope2 = exp2f(-(float)(h + 1)) * LOG2E * (float)dil;
                float mx = -1e30f;
#pragma unroll
                for (int t = 0; t < 10; ++t)
#pragma unroll
                    for (int rg = 0; rg < 4; ++rg) { const int ki = 16 * (T0 + t) + 4 * fq + rg, j = ki - i;
                        const bool valid = (j >= 0) && (j <= 128) && (n > 0 || ki >= 128);
                        const float sv = valid ? sa[t][rg] - slope2 * (float)(128 - j) : -1e30f;
                        sa[t][rg] = sv; mx = fmaxf(mx, sv); }
                mx = fmaxf(mx, __shfl_xor(mx, 16)); mx = fmaxf(mx, __shfl_xor(mx, 32));
                float sum = 0.f;
#pragma unroll
                for (int t = 0; t < 10; ++t)
#pragma unroll
                    for (int rg = 0; rg < 4; ++rg) { const float p = __builtin_amdgcn_exp2f(sa[t][rg] - mx); sa[t][rg] = p; sum += p; }
                sum += __shfl_xor(sum, 16); sum += __shfl_xor(sum, 32);
                f32x4 oa[8];
#pragma unroll
                for (int ht = 0; ht < 8; ++ht) oa[ht] = (f32x4){0.f, 0.f, 0.f, 0.f};
                { bf16x8 vf[2][8];
#define ATT_LDV(buf, kk_) do { const LAS unsigned char* vb = Vs + (16 * (T0 + 2 * (kk_)) + 4 * fq + (fr >> 2)) * 288 + (fr & 3) * 8; \
                        _Pragma("unroll") for (int ht = 0; ht < 8; ++ht) { const s16x4 t1 = ds_tr16(vb + ht * 32), t2 = ds_tr16(vb + ht * 32 + 16 * 288); \
                            vf[buf][ht] = __builtin_bit_cast(bf16x8, __builtin_shufflevector(t1, t2, 0, 1, 2, 3, 4, 5, 6, 7)); } } while (0)
                  ATT_LDV(0, 0);
#pragma unroll
                  for (int kk = 0; kk < 5; ++kk) {
                      if (kk + 1 < 5) ATT_LDV((kk + 1) & 1, kk + 1);
                      asm volatile("" : "+v"(vf[kk & 1][0]), "+v"(vf[kk & 1][1]), "+v"(vf[kk & 1][2]), "+v"(vf[kk & 1][3]), "+v"(vf[kk & 1][4]), "+v"(vf[kk & 1][5]), "+v"(vf[kk & 1][6]), "+v"(vf[kk & 1][7]));
                      u32x4 pw; pw.x = pg8::cvt_pk_bf16(sa[2 * kk][0], sa[2 * kk][1]); pw.y = pg8::cvt_pk_bf16(sa[2 * kk][2], sa[2 * kk][3]);
                      pw.z = pg8::cvt_pk_bf16(sa[2 * kk + 1][0], sa[2 * kk + 1][1]); pw.w = pg8::cvt_pk_bf16(sa[2 * kk + 1][2], sa[2 * kk + 1][3]);
                      const bf16x8 pf = __builtin_bit_cast(bf16x8, pw);
#pragma unroll
                      for (int ht = 0; ht < 8; ++ht) oa[ht] = __builtin_amdgcn_mfma_f32_16x16x32_bf16(vf[kk & 1][ht], pf, oa[ht], 0, 0, 0);
                  }
#undef ATT_LDV
                }
                const float inv = 1.0f / sum;
                bf16_t* orow = OB + ((size_t)b * S + qpos) * DG + h * 128 + 4 * fq;
#pragma unroll
                for (int ht = 0; ht < 8; ++ht) { u32x2 o; o.x = pg8::cvt_pk_bf16(oa[ht][0] * inv, oa[ht][1] * inv); o.y = pg8::cvt_pk_bf16(oa[ht][2] * inv, oa[ht][3] * inv); *(u32x2*)(orow + 16 * ht) = o; }
                if (fq == 0) LSE[((size_t)b * S + qpos) * 8 + h] = mx + log2f(sum);
                __syncthreads();
            }
        }
        if (BOTH(3) || rep + 1 < NREP(3)) GRID_BAR();
    } }

    if (IN(4)) { for (int rep = 0; rep < NREP(4); ++rep) {
        for (int i0 = gtid; i0 < S * (DG / 8); i0 += 4 * GT) {
            u32x4 ob[4][3]; float ls[4][3];
#pragma unroll
            for (int u = 0; u < 4; ++u) { const int i = i0 + u * GT; const bool ok = i < S * (DG / 8); const int row = ok ? i / (DG / 8) : 0, col = ok ? (i % (DG / 8)) * 8 : 0, h = col >> 7;
#pragma unroll
                for (int b = 0; b < 3; ++b) { ob[u][b] = *(const u32x4*)(OB + ((size_t)b * S + row) * DG + col); ls[u][b] = LSE[((size_t)b * S + row) * 8 + h]; } }
#pragma unroll
            for (int u = 0; u < 4; ++u) { const int i = i0 + u * GT; if (i >= S * (DG / 8)) continue; const int row = i / (DG / 8), col = (i % (DG / 8)) * 8;
                const float l0 = ls[u][0], l1 = ls[u][1], l2 = ls[u][2];
                const float mx = fmaxf(fmaxf(l0, l1), l2);
                const float w0 = exp2f(l0 - mx), w1 = exp2f(l1 - mx), w2 = exp2f(l2 - mx), inv = 1.0f / (w0 + w1 + w2);
                u32x4 o;
#pragma unroll
                for (int q = 0; q < 4; ++q) { const unsigned o0 = ob[u][0][q], o1 = ob[u][1][q], o2 = ob[u][2][q];
                    const float ya = (w0 * bflo(o0) + w1 * bflo(o1) + w2 * bflo(o2)) * inv, yb = (w0 * bfhi(o0) + w1 * bfhi(o1) + w2 * bfhi(o2)) * inv;
                    o[q] = pk2(ya, yb); }
                *(u32x4*)(Y + (size_t)row * D + DG + col) = o; }
        }
        if (BOTH(4) || rep + 1 < NREP(4)) GRID_BAR();
    } }

    if (IN(5)) { for (int rep = 0; rep < NREP(5); ++rep) {
        pg8::Gemm g{Y, WOT, D}; pg8::DenseOrder So{S / 256, D / 256, G, bx, (S / 256) * (D / 256)}; pg8::EpiZ E{Z, x, ADA};
        pg8::gemm_phase<pg8::EpiZ, pg8::DenseOrder, false>(lds, g, So, E, nullptr);
        if (BOTH(5) || rep + 1 < NREP(5)) GRID_BAR();
    } }

    if (IN(6)) { for (int rep = 0; rep < NREP(6); ++rep) {
        constexpr int HS = D + 4;
        LAS float* h2f = (LAS float*)lds;
        for (int rb = bx; rb < S / 16; rb += G) {
            f32x4 lg[8], lb[8], lsh[8], lsc[8];
            { unsigned lo = (unsigned)lane * 16u; asm volatile("" : "+v"(lo));
#pragma unroll
              for (int j = 0; j < 8; ++j) { const unsigned of = lo + (unsigned)(j * 1024); lg[j] = ldf4(ln1_g, of); lb[j] = ldf4(ln1_b, of); lsh[j] = ldf4(ADA + 3 * D, of); lsc[j] = ldf4(ADA + 4 * D, of); } }
#pragma unroll
            for (int rr = 0; rr < 2; ++rr) {
                const int lr = wave * 2 + rr; const size_t row = (size_t)rb * 16 + lr;
                const bf16_t* zr = Z + row * D; bf16_t* x1r = X1 + row * D; bf16_t* h2r = H2 + row * D;
                unsigned lo16 = (unsigned)lane * 16u; asm volatile("" : "+v"(lo16));
                f32x4 v[8]; float s = 0.f;
#pragma unroll
                for (int j = 0; j < 8; ++j) { const unsigned of = lo16 + (unsigned)(j * 1024); v[j] = uph4(ldu2(zr, of >> 1)); s += (v[j][0] + v[j][1]) + (v[j][2] + v[j][3]); }
                const float mean = wave_sum(s) * (1.0f / D); float s2 = 0.f;
#pragma unroll
                for (int j = 0; j < 8; ++j) { v[j] = v[j] - mean; s2 += (v[j][0] * v[j][0] + v[j][1] * v[j][1]) + (v[j][2] * v[j][2] + v[j][3] * v[j][3]); }
                const float rstd = 1.0f / sqrtf(wave_sum(s2) * (1.0f / D) + LN_EPS);
#pragma unroll
                for (int j = 0; j < 8; ++j) { const unsigned of = lo16 + (unsigned)(j * 1024);
                    const f32x4 x1 = v[j] * rstd * lg[j] + lb[j];
                    { u32x2 w1; w1.x = pkh(x1[0], x1[1]); w1.y = pkh(x1[2], x1[3]); *(u32x2*)((char*)x1r + (of >> 1)) = w1; }
                    const f32x4 sh = lsh[j], sc = lsc[j];
                    const f32x4 hv = x1 * (sc + 1.0f) + sh;
                    u32x2 w; w.x = r8h(pkh(hv[0], hv[1])); w.y = r8h(pkh(hv[2], hv[3]));
                    *(u32x2*)((char*)h2r + (of >> 1)) = w;
                    *(LAS f32x4*)((LAS char*)h2f + lr * (HS * 4) + of) = hv; }
            }
            __syncthreads();
            const int e = tid & 31;
            { int lo_ = lane; asm volatile("" : "+v"(lo_));
              const int r16 = lo_ & 15, kq4 = lo_ >> 4;
              f32x4 c0 = (f32x4){0.f, 0.f, 0.f, 0.f}, c1 = (f32x4){0.f, 0.f, 0.f, 0.f};
              const float* wb = WRT + (size_t)r16 * D + wave * 256 + 4 * kq4;
              const LAS float* hb = h2f + r16 * HS + wave * 256 + 4 * kq4;
              f32x4 bw[4][2];
#pragma unroll
              for (int qt = 0; qt < 4; ++qt) {
#pragma unroll
                  for (int gg = 0; gg < 4; ++gg) { bw[gg][0] = *(const f32x4*)(wb + 16 * (4 * qt + gg)); bw[gg][1] = *(const f32x4*)(wb + 16 * D + 16 * (4 * qt + gg)); }
                  asm volatile("" : "+v"(bw[0][0]), "+v"(bw[0][1]), "+v"(bw[1][0]), "+v"(bw[1][1]), "+v"(bw[2][0]), "+v"(bw[2][1]), "+v"(bw[3][0]), "+v"(bw[3][1]));
#pragma unroll
                  for (int gg = 0; gg < 4; ++gg) {
                      const f32x4 a4 = *(const LAS f32x4*)(hb + 16 * (4 * qt + gg));
                      const f32x4 b0 = bw[gg][0], b1 = bw[gg][1];
#pragma unroll
                      for (int s = 0; s < 4; ++s) { c0 = __builtin_amdgcn_mfma_f32_16x16x4f32(a4[s], b0[s], c0, 0, 0, 0); c1 = __builtin_amdgcn_mfma_f32_16x16x4f32(a4[s], b1[s], c1, 0, 0, 0); }
                  }
              }
              __syncthreads();
              LAS float* part = (LAS float*)lds;
#pragma unroll
              for (int rg = 0; rg < 4; ++rg) { part[(wave * 16 + 4 * kq4 + rg) * 32 + r16] = c0[rg]; part[(wave * 16 + 4 * kq4 + rg) * 32 + 16 + r16] = c1[rg]; }
            }
            __syncthreads();
            LAS float* part = (LAS float*)lds;
            LAS int* selc = (LAS int*)(lds + 65536);
            { const int r = tid >> 5; float v = b_router[e];
#pragma unroll
              for (int q = 0; q < 8; ++q) v += part[(q * 16 + r) * 32 + e];
              float tv[4]; int ti[4]; int mine = 0;
#pragma unroll
              for (int k = 0; k < 4; ++k) { float bv = v; int bi = e;
#pragma unroll
#define T4_STEP(ctrl) do { const float ov = __builtin_bit_cast(float, __builtin_amdgcn_update_dpp(0, __builtin_bit_cast(int, bv), ctrl, 0xF, 0xF, false)); const int oi = __builtin_amdgcn_update_dpp(0, bi, ctrl, 0xF, 0xF, false); \
                      if (ov > bv || (ov == bv && oi < bi)) { bv = ov; bi = oi; } } while (0)
                  T4_STEP(0xB1); T4_STEP(0x4E); T4_STEP(0x141); T4_STEP(0x140);
#undef T4_STEP
                  { const float ov = __shfl_xor(bv, 16); const int oi = __shfl_xor(bi, 16); if (ov > bv || (ov == bv && oi < bi)) { bv = ov; bi = oi; } }
                  tv[k] = bv; ti[k] = bi; if (bi == e) { v = -3.0e38f; mine = 1; } }
              selc[r * 32 + e] = mine;
              if (e == 0) { const size_t row = (size_t)rb * 16 + r;
                  const float e1 = __expf(tv[1] - tv[0]), e2 = __expf(tv[2] - tv[0]), e3 = __expf(tv[3] - tv[0]), inv = 1.0f / (1.0f + e1 + e2 + e3);
                  *(int4*)(TOPI + row * 4) = make_int4(ti[0], ti[1], ti[2], ti[3]);
                  *(f32x4*)(TOPG + row * 4) = (f32x4){inv, e1 * inv, e2 * inv, e3 * inv}; } }
            __syncthreads();
            if (tid < NE) { int cnt = 0;
#pragma unroll
                for (int q = 0; q < 16; ++q) cnt += selc[q * 32 + tid];
                RBC[rb * NE + tid] = cnt; }
            __syncthreads();
        }
        if (BOTH(6) || rep + 1 < NREP(6)) GRID_BAR();
    } }

    if (IN(7)) { for (int rep = 0; rep < NREP(7); ++rep) {
        LAS int* part = (LAS int*)lds;
        LAS int* tstart = (LAS int*)(lds + 4096);
        LAS int* base = (LAS int*)(lds + 8192);
        LAS int* sel = (LAS int*)(lds + 12288);
        LAS int* red = (LAS int*)(lds + 16384);
        { const int e = tid & 31, pt = tid >> 5; int s = 0; for (int q = 0; q < 32; ++q) s += RBC[(pt * 32 + q) * NE + e]; part[pt * 32 + e] = s; }
        __syncthreads();
        if (tid == 0) { int acc = 0; for (int e = 0; e < NE; ++e) { int tot = 0; for (int pt = 0; pt < 16; ++pt) tot += part[pt * 32 + e]; tstart[e] = acc; tstart[40 + e] = tot; acc += (tot + 255) >> 8; } tstart[NE] = acc; }
        __syncthreads();
        if (bx == 0) { if (tid == 0) TEXP[0] = tstart[NE]; if (tid < NE) for (int t = tstart[tid]; t < tstart[tid + 1]; ++t) { const int left = tstart[40 + tid] - 256 * (t - tstart[tid]); TEXP[1 + t] = tid | ((left < 256 ? left : 256) << 8);
            const int R = tstart[tid + 1] - tstart[tid]; TEXP[512 + t] = (t - tstart[tid]) | (R << 8) | ((tstart[40 + tid] - 256 * (R - 1)) << 16); } }
        for (int rb = bx; rb < S / 16; rb += G) {
            { const int e = tid & 31, j = tid >> 5, pt = rb >> 5, q1 = pt * 32 + j, q2 = q1 + 16;
              int v = 0; if (q1 < rb) v += RBC[q1 * NE + e]; if (q2 < rb) v += RBC[q2 * NE + e]; red[j * 32 + e] = v; }
            if (tid >= 64 && tid < 128) sel[tid - 64] = TOPI[(size_t)rb * 64 + (tid - 64)];
            __syncthreads();
            if (tid < NE) { const int e = tid, pt = rb >> 5; int s = tstart[e] * 256; for (int q = 0; q < pt; ++q) s += part[q * 32 + e];
#pragma unroll
                for (int j = 0; j < 16; ++j) s += red[j * 32 + e];
                base[e] = s; }
            __syncthreads();
            if (tid < 64) { const int e = sel[tid]; int rank = 0;
#pragma unroll
                for (int q = 0; q < 64; ++q) rank += (q < tid && sel[q] == e) ? 1 : 0;
                const int pos = base[e] + rank, token = rb * 16 + (tid >> 2);
                TOK[pos] = token; GATEP[pos] = TOPG[(size_t)rb * 64 + tid]; POSOF[(size_t)rb * 64 + tid] = pos; }
            __syncthreads();
        }
        if (BOTH(7) || rep + 1 < NREP(7)) GRID_BAR();
    } }

    if (IN(8)) { for (int rep = 0; rep < NREP(8); ++rep) {
        LAS int* texp = (LAS int*)(lds + TEXP_OFF);
        const int NT = TEXP[0];
        for (int t = tid; t < CAP_TILES; t += NTHR) { texp[t] = t < NT ? TEXP[1 + t] : 0; texp[256 + t] = t < NT ? TEXP[512 + t] : 0; }
        __syncthreads();
        pg8::MoeOrder So{NT, NW1 / 256, G, bx, NW1, texp}; pg8::EpiSwiglu E{ACT, b_e1, 128, 64};
#if MK_ABL8 >= 0
        rg::moe_gemm<pg8::EpiSwiglu, pg8::MoeOrder, true, MK_ABL8>(lds, So, E, H2, TOK, w_e1, NW1); GRID_BAR();
#endif
        rg::moe_gemm<pg8::EpiSwiglu, pg8::MoeOrder, true>(lds, So, E, H2, TOK, w_e1, NW1);
        if (BOTH(8) || rep + 1 < NREP(8)) GRID_BAR();
    } }

    if (IN(9)) { for (int rep = 0; rep < NREP(9); ++rep) {
        LAS int* texp = (LAS int*)(lds + TEXP_OFF);
        const int NT = TEXP[0];
        for (int t = tid; t < CAP_TILES; t += NTHR) { texp[t] = t < NT ? TEXP[1 + t] : 0; texp[256 + t] = t < NT ? TEXP[512 + t] : 0; }
        __syncthreads();
        pg8::MoeOrder So{NT, D / 256, G, bx, D, texp}; pg8::EpiContrib E{CONTRIB, b_e2, GATEP, 128, 64};
        rg::moe_gemm<pg8::EpiContrib, pg8::MoeOrder, false>(lds, So, E, ACT, nullptr, w_e2, D);
        if (BOTH(9) || rep + 1 < NREP(9)) GRID_BAR();
    } }

    if (IN(10)) {
        unsigned bad = 0u;
        if (ONE) bad = (__hip_atomic_load(ctl + CW_BAR + XB_TMO, RLX_AGENT) != 0u) ? 1u : 0u;
        f32x4 g2v[8], l2g[8], l2b[8];
        { unsigned lo = (unsigned)lane * 16u; asm volatile("" : "+v"(lo));
#pragma unroll
          for (int j = 0; j < 8; ++j) { const unsigned of = lo + (unsigned)(j * 1024); g2v[j] = ldf4(ADA + 5 * D, of); l2g[j] = ldf4(ln2_g, of); l2b[j] = ldf4(ln2_b, of); } }
        for (int row = gw; row < S; row += NGW) {
            const int p0 = POSOF[row * 4 + 0], p1 = POSOF[row * 4 + 1], p2 = POSOF[row * 4 + 2], p3 = POSOF[row * 4 + 3];
            const bf16_t* c0r = CONTRIB + (size_t)p0 * D; const bf16_t* c1r = CONTRIB + (size_t)p1 * D; const bf16_t* c2r = CONTRIB + (size_t)p2 * D; const bf16_t* c3r = CONTRIB + (size_t)p3 * D;
            const bf16_t* xr = X1 + (size_t)row * D; float* orow = out + (size_t)row * D;
            unsigned lo16 = (unsigned)lane * 16u; asm volatile("" : "+v"(lo16));
            f32x4 v[8]; float s = 0.f;
#pragma unroll
            for (int hh = 0; hh < 2; ++hh) {
                u32x2 q0[4], q1[4], q2[4], q3[4]; f32x4 xv[4];
#pragma unroll
                for (int jj = 0; jj < 4; ++jj) { const unsigned of = lo16 + (unsigned)((4 * hh + jj) * 1024); q0[jj] = ldu2(c0r, of >> 1); q1[jj] = ldu2(c1r, of >> 1); q2[jj] = ldu2(c2r, of >> 1); q3[jj] = ldu2(c3r, of >> 1); xv[jj] = uph4(ldu2(xr, of >> 1)); }
                asm volatile("" : "+v"(q0[0]), "+v"(q0[1]), "+v"(q0[2]), "+v"(q0[3]), "+v"(q1[0]), "+v"(q1[1]), "+v"(q1[2]), "+v"(q1[3]), "+v"(q2[0]), "+v"(q2[1]), "+v"(q2[2]), "+v"(q2[3]),
                             "+v"(q3[0]), "+v"(q3[1]), "+v"(q3[2]), "+v"(q3[3]), "+v"(xv[0]), "+v"(xv[1]), "+v"(xv[2]), "+v"(xv[3]));
#pragma unroll
                for (int jj = 0; jj < 4; ++jj) { const int j = 4 * hh + jj;
                    const u32x2 c0 = q0[jj], c1 = q1[jj], c2 = q2[jj], c3 = q3[jj];
                    f32x4 y;
                    y[0] = ((bflo(c0.x) + bflo(c1.x)) + bflo(c2.x)) + bflo(c3.x); y[1] = ((bfhi(c0.x) + bfhi(c1.x)) + bfhi(c2.x)) + bfhi(c3.x);
                    y[2] = ((bflo(c0.y) + bflo(c1.y)) + bflo(c2.y)) + bflo(c3.y); y[3] = ((bfhi(c0.y) + bfhi(c1.y)) + bfhi(c2.y)) + bfhi(c3.y);
                    v[j] = xv[jj] * ALPHA + g2v[j] * y;
                    s += (v[j][0] + v[j][1]) + (v[j][2] + v[j][3]); }
            }
            const float mean = wave_sum(s) * (1.0f / D); float s2 = 0.f;
#pragma unroll
            for (int j = 0; j < 8; ++j) { v[j] = v[j] - mean; s2 += (v[j][0] * v[j][0] + v[j][1] * v[j][1]) + (v[j][2] * v[j][2] + v[j][3] * v[j][3]); }
            const float rstd = 1.0f / sqrtf(wave_sum(s2) * (1.0f / D) + LN_EPS);
#pragma unroll
            for (int j = 0; j < 8; ++j) { const unsigned of = lo16 + (unsigned)(j * 1024);
                f32x4 o = v[j] * rstd * l2g[j] + l2b[j];
                if (bad) { const float qn = __builtin_nanf(""); o = (f32x4){qn, qn, qn, qn}; }
                *(f32x4*)((char*)orow + of) = o; }
        }
    }
#undef IN
#undef BOTH
#undef GRID_BAR
}

extern "C" void kernel_launch(void* const* d_in, const int* in_sizes, int n_in, void* d_out, int out_size, void* d_ws, size_t ws_size, hipStream_t stream) {
    static int grid = 0;
    if (grid == 0) {
        if (n_in != 20 || out_size != S * D || ws_size < WS_END) { fprintf(stderr, "kernel_launch: unexpected shapes (n_in %d, out %d, ws %zu)\n", n_in, out_size, ws_size); grid = -1; return; }
        int dev = 0, cus = 0, per_cu = 0;
        if (hipGetDevice(&dev) != hipSuccess || hipDeviceGetAttribute(&cus, hipDeviceAttributeMultiprocessorCount, dev) != hipSuccess) { grid = -1; return; }
        if (hipFuncSetAttribute((const void*)fwd_kernel, hipFuncAttributeMaxDynamicSharedMemorySize, LDS_BYTES) != hipSuccess) { fprintf(stderr, "kernel_launch: hipFuncSetAttribute failed\n"); grid = -1; return; }
        if (hipOccupancyMaxActiveBlocksPerMultiprocessor(&per_cu, (const void*)fwd_kernel, NTHR, LDS_BYTES) != hipSuccess || per_cu < 1) { fprintf(stderr, "kernel_launch: occupancy query says %d\n", per_cu); }
        (void)hipGetLastError();
        grid = cus;
    }
    if (grid < 0) return;
    (void)hipMemsetAsync((char*)d_ws + WS_CTL, 0, CTL_ZERO_BYTES, stream);
    Args a{};
    for (int i = 0; i < 20; ++i) a.in[i] = (const float*)d_in[i];
    a.out = (float*)d_out; a.ws = (unsigned char*)d_ws; a.pad = 0;
    if (MK_N_LAUNCHES == 1) {
        a.ph_lo = 0; a.ph_hi = NPH; a.li = 0;
        hipLaunchKernelGGL(fwd_kernel, dim3(grid), dim3(NTHR), LDS_BYTES, stream, a);
    } else {
        for (int p = 0; p < NPH; ++p) { a.ph_lo = p; a.ph_hi = p + 1; a.li = p; hipLaunchKernelGGL(fwd_kernel, dim3(grid), dim3(NTHR), LDS_BYTES, stream, a); }
    }
}
```

```cpp
#include <hip/hip_runtime.h>
#include <cstdio>
#include <cstdint>

#ifndef MK_N_LAUNCHES
#define MK_N_LAUNCHES 1
#endif

#ifndef MK_ABL8
#define MK_ABL8 -1
#endif
#ifndef MK_DUP_MASK
#define MK_DUP_MASK 0
#endif
#define NREP(k) ((((MK_DUP_MASK) >> (k)) & 1) ? 2 : 1)
#define GAS __attribute__((address_space(1)))
#define LAS __attribute__((address_space(3)))
typedef unsigned short bf16_t;
typedef short bf16x8 __attribute__((ext_vector_type(8)));
typedef float f32x4 __attribute__((ext_vector_type(4)));
typedef float f32x2 __attribute__((ext_vector_type(2)));
typedef unsigned u32x4 __attribute__((ext_vector_type(4)));
typedef unsigned u32x2 __attribute__((ext_vector_type(2)));
typedef GAS unsigned gu32;

constexpr int S = 8192, D = 2048, NPROJ = 5120, DG = 1024, NH = 8, HD = 128, NE = 32, TOPK = 4, DE = 2048, NW1 = 4096;
constexpr int CAP_TILES = 160, CAP = CAP_TILES * 256;
constexpr float LN_EPS = 1e-5f;
constexpr float ALPHA = 1.189207115002721f;
constexpr float LOG2E = 1.4426950408889634f;
constexpr float QSCALE = 0.08838834764831845f * LOG2E;
constexpr int NWAVES = 8, NTHR = 512;

constexpr size_t MiB = 1u << 20;
constexpr size_t WS_CTL = 0, CTL_ZERO_BYTES = 32768;
constexpr size_t WS_WIN = 2 * MiB;
constexpr size_t WS_WO = 22 * MiB;
constexpr size_t WS_SMALL = 30 * MiB;
constexpr size_t WS_H = 32 * MiB;
constexpr size_t WS_PROJ = 64 * MiB;
constexpr size_t WS_OB = 144 * MiB;
constexpr size_t WS_Y = 192 * MiB;
constexpr size_t WS_Z = 224 * MiB;
constexpr size_t WS_X1 = 288 * MiB;
constexpr size_t WS_H2 = 352 * MiB;
constexpr size_t WS_ACT = 386 * MiB;
constexpr size_t WS_CONTRIB = 546 * MiB;
constexpr size_t WS_PADA = 1474 * MiB;
constexpr size_t WS_END = 1476 * MiB;
constexpr size_t SM_TOPI = 0, SM_TOPG = 128 * 1024, SM_RBC = 256 * 1024, SM_TOK = 320 * 1024, SM_GATEP = 480 * 1024, SM_POSOF = 640 * 1024, SM_TEXP = 768 * 1024, SM_LSE = 1024 * 1024;
constexpr int CW_TMO = 0, CW_CODE = 1, CW_BAR = 4096;
static_assert((CW_BAR + 3456) * 4 <= (int)CTL_ZERO_BYTES, "barrier words inside the memset region");

constexpr int RING_BYTES = 131072;
constexpr int LDS_BYTES = 147456;
constexpr int ROWTAB_OFF = RING_BYTES;
constexpr int TEXP_OFF = ROWTAB_OFF + 12 * 1024;
constexpr int MISC_OFF = LDS_BYTES - 512;
static_assert(TEXP_OFF + 2048 <= MISC_OFF && CAP_TILES <= 256, "LDS map");

#define RLX_AGENT __ATOMIC_RELAXED, __HIP_MEMORY_SCOPE_AGENT
#define LDS_WAIT() asm volatile("s_waitcnt lgkmcnt(0)" ::: "memory")
#define VM_WAIT() asm volatile("s_waitcnt vmcnt(0)" ::: "memory")
__device__ __forceinline__ unsigned f2bf(float f) { unsigned u = __builtin_bit_cast(unsigned, f); return (u + 0x7fffu + ((u >> 16) & 1u)) >> 16; }
__device__ __forceinline__ unsigned pk2(float lo, float hi) { return f2bf(lo) | (f2bf(hi) << 16); }
typedef _Float16 h16x2 __attribute__((ext_vector_type(2)));
typedef _Float16 h16x8 __attribute__((ext_vector_type(8)));
__device__ __forceinline__ float h2f1(unsigned short h) { return (float)__builtin_bit_cast(_Float16, h); }
__device__ __forceinline__ f32x4 uph4(u32x2 t) { const unsigned w0 = t.x, w1 = t.y; f32x4 r; r[0] = h2f1((unsigned short)(w0 & 0xffffu)); r[1] = h2f1((unsigned short)(w0 >> 16)); r[2] = h2f1((unsigned short)(w1 & 0xffffu)); r[3] = h2f1((unsigned short)(w1 >> 16)); return r; }
__device__ __forceinline__ unsigned r8h(unsigned w) { return (w + 0x00040004u) & 0xfff8fff8u; }
__device__ __forceinline__ unsigned pkh(float lo, float hi) { h16x2 v; v.x = (_Float16)lo; v.y = (_Float16)hi; return __builtin_bit_cast(unsigned, v); }
__device__ __forceinline__ float bflo(unsigned p) { return __uint_as_float(p << 16); }
__device__ __forceinline__ float bfhi(unsigned p) { return __uint_as_float(p & 0xffff0000u); }
__device__ __forceinline__ float bf1(bf16_t b) { return __uint_as_float((unsigned)b << 16); }
__device__ __forceinline__ f32x4 ldf4(const void* base, unsigned byteoff) { return *(const f32x4*)((const char*)base + byteoff); }
__device__ __forceinline__ u32x2 ldu2(const void* base, unsigned byteoff) { return *(const u32x2*)((const char*)base + byteoff); }
__device__ __forceinline__ float wave_sum(float v) {
#define WS_DPP(x, ctrl, rmask) __builtin_bit_cast(float, __builtin_amdgcn_update_dpp(0, __builtin_bit_cast(int, x), ctrl, rmask, 0xF, false))
    v += WS_DPP(v, 0xB1, 0xF);
    v += WS_DPP(v, 0x4E, 0xF);
    v += WS_DPP(v, 0x141, 0xF);
    v += WS_DPP(v, 0x140, 0xF);
    v += WS_DPP(v, 0x142, 0xA);
    v += WS_DPP(v, 0x143, 0xC);
#undef WS_DPP
    return __builtin_bit_cast(float, __builtin_amdgcn_readlane(__builtin_bit_cast(int, v), 63));
}
__device__ __forceinline__ float wave_max(float v) {
#pragma unroll
    for (int o = 1; o < 64; o <<= 1) v = fmaxf(v, __shfl_xor(v, o));
    return v;
}

typedef short s16x4 __attribute__((ext_vector_type(4)));
__device__ __forceinline__ s16x4 ds_tr16(const LAS unsigned char* p) { return __builtin_bit_cast(s16x4, __builtin_amdgcn_ds_read_tr16_b64_v4i16((LAS s16x4*)p)); }

namespace pg8 {
#define PG8_LAS __attribute__((address_space(3)))
constexpr int BM = 256, BK = 64, HALF = 128, HTB = HALF * BK * 2, STAGE_BYTES = 8 * HTB, NXCD = 8, WGM = 8;
__host__ __device__ __forceinline__ int lds_byte(int r, int c) { const int st = (r >> 4) * 2 + (c >> 5), rr = r & 15, cc = c & 31, ob = rr * 64 + cc * 2; return st * 1024 + (ob ^ (((ob >> 9) & 1) << 5)); }
__host__ __device__ __forceinline__ void stage_rc(int b, int& R, int& C) { const int st = b / 1024, sb = b % 1024, swz = sb ^ (((sb >> 9) & 1) << 5); R = (st >> 1) * 16 + swz / 64; C = (st & 1) * 32 + (swz % 64) / 2; }
__host__ __device__ __forceinline__ int perm32(int rho) { const int n = rho >> 4, i = rho & 15; return 8 * (i >> 2) + 4 * n + (i & 3); }

struct Unit { int pm, pn, arow, brow, e, hn, nv; };
struct Gemm { const bf16_t* A; const bf16_t* Bt; int K; };

__device__ __forceinline__ void tile_of(int L, int nM, int nN, int& pm, int& pn) {
    const int nwg = nM * nN; int wgid = L;
    { const int q = nwg / NXCD, r = nwg % NXCD, xcd = wgid % NXCD, off = wgid / NXCD; wgid = (xcd < r ? xcd * (q + 1) : r * (q + 1) + (xcd - r) * q) + off; }
    const int nig = WGM * nN, gid = wgid / nig, fm = gid * WGM, gsz = (nM - fm) < WGM ? (nM - fm) : WGM;
    pm = fm + ((wgid % nig) % gsz); pn = (wgid % nig) / gsz;
}
struct DenseOrder {
    int nM, nN, G, c, cnt;
    __device__ __forceinline__ bool next(int i, Unit& u) const {
        const int L = i * G + c; if (L >= cnt) return false;
        tile_of(L, nM, nN, u.pm, u.pn); u.arow = u.pm * BM; u.brow = u.pn * BM; u.e = 0; u.hn = -1; u.nv = BM; return true;
    }
};
struct HalfOrder {
    int nM, nN, G, c, L0;
    __device__ __forceinline__ bool next(int i, Unit& u) const {
        const int Lh = i * G + c; if (Lh >= 2 * (nM * nN - L0)) return false;
        tile_of(L0 + (Lh >> 1), nM, nN, u.pm, u.pn); u.hn = Lh & 1; u.arow = u.pm * BM; u.brow = u.pn * BM + u.hn * HALF; u.e = 0; u.nv = BM; return true;
    }
};
struct MoeOrder {
    int nM, nN, G, c, N; const LAS int* texp;
    __device__ __forceinline__ bool next(int i, Unit& u) const {
        const int L = i * G + c, nwg = nM * nN; if (L >= nwg) return false;
        int wgid = L; { const int q = nwg / NXCD, r = nwg % NXCD, xcd = wgid % NXCD, off = wgid / NXCD; wgid = (xcd < r ? xcd * (q + 1) : r * (q + 1) + (xcd - r) * q) + off; }
        const int t0 = wgid >> __builtin_ctz(nN), w1 = __builtin_amdgcn_readfirstlane(texp[t0]), w2 = __builtin_amdgcn_readfirstlane(texp[256 + t0]);
        const int e = w1 & 255, lo = t0 - (w2 & 255), R = (w2 >> 8) & 255, idx = wgid - lo * nN;
        const int pn_ = (int)(((float)idx + 0.5f) * __builtin_amdgcn_rcpf((float)R));
        u.pn = pn_; u.pm = lo + idx - pn_ * R; u.arow = u.pm * BM; u.e = e; u.brow = e * N + u.pn * BM; u.hn = -1; u.nv = (u.pm == lo + R - 1) ? ((w2 >> 16) & 511) : BM; return true;
    }
};

__device__ __forceinline__ unsigned cvt_pk_bf16(float lo, float hi) { unsigned r; asm volatile("v_cvt_pk_bf16_f32 %0, %1, %2" : "=v"(r) : "v"(lo), "v"(hi)); return r; }
__device__ __forceinline__ f32x2 gelu_pk(f32x2 v) {
    const f32x2 av = __builtin_elementwise_abs(v), d = av * 0.2316418882f + 1.0f;
    f32x2 t; t.x = __builtin_amdgcn_rcpf(d.x); t.y = __builtin_amdgcn_rcpf(d.y);
    f32x2 q = t * 0.5307027145f + (-0.7265760135f); q = q * t + 0.7107068705f; q = q * t + (-0.142248368f); q = q * t + 0.127414796f; q = q * t;
    const f32x2 s = (v * v) * (-0.72134752044f);
    f32x2 e; e.x = __builtin_amdgcn_exp2f(s.x); e.y = __builtin_amdgcn_exp2f(s.y);
    const f32x2 m = v * (q * e), r = v - m;
    f32x2 o; o.x = v.x < 0.f ? m.x : r.x; o.y = v.y < 0.f ? m.y : r.y; return o;
}

struct EpiProj {
    static constexpr bool PERM = true;
    bf16_t* O;
    __device__ __forceinline__ void operator()(const f32x4 (&acc)[2][2][4][2], const Unit& u, int wr, int wc, int fr, int fq) const {
        const int row0 = u.pm * BM + wr * 64 + fr, col0 = u.pn * BM + wc * 32 + 8 * fq + (u.hn > 0 ? HALF : 0);
        const int mode = u.pn < 8 ? 1 : (u.pn < 12 ? 2 : 0), nbj = u.hn < 0 ? 2 : 1;
#pragma unroll
        for (int ai = 0; ai < 2; ++ai)
#pragma unroll
            for (int m = 0; m < 4; ++m) { bf16_t* rowp = O + (size_t)(row0 + ai * HALF + m * 16) * NPROJ + col0;
#pragma unroll
                for (int bj = 0; bj < 2; ++bj) { if (bj >= nbj) continue; f32x4 v0 = acc[ai][bj][m][0], v1 = acc[ai][bj][m][1];
                    if (mode == 1) { f32x2 a = gelu_pk((f32x2){v0[0], v0[1]}), b = gelu_pk((f32x2){v0[2], v0[3]}), c = gelu_pk((f32x2){v1[0], v1[1]}), d = gelu_pk((f32x2){v1[2], v1[3]});
                        v0 = (f32x4){a.x, a.y, b.x, b.y}; v1 = (f32x4){c.x, c.y, d.x, d.y}; }
                    else if (mode == 2) { v0 = v0 * QSCALE; v1 = v1 * QSCALE; }
                    u32x4 w; w.x = cvt_pk_bf16(v0[0], v0[1]); w.y = cvt_pk_bf16(v0[2], v0[3]); w.z = cvt_pk_bf16(v1[0], v1[1]); w.w = cvt_pk_bf16(v1[2], v1[3]);
                    *(u32x4*)(rowp + bj * HALF) = w; } }
    }
};
struct EpiZ {
    static constexpr bool PERM = false;
    bf16_t* Z; const float* x; const float* ada;
    __device__ __forceinline__ void operator()(const f32x4 (&acc)[2][2][4][2], const Unit& u, int wr, int wc, int fr, int fq) const {
        const int row0 = u.pm * BM + wr * 64 + fr, col0 = u.pn * BM + wc * 32 + 4 * fq;
        f32x4 gv[2][2];
#pragma unroll
        for (int bj = 0; bj < 2; ++bj)
#pragma unroll
            for (int n = 0; n < 2; ++n) gv[bj][n] = *(const f32x4*)(ada + 2 * D + col0 + bj * HALF + n * 16);
        f32x4 xg[2][2][2][2];
#define EZ_LD(buf, g) do { _Pragma("unroll") for (int s = 0; s < 2; ++s) { const int ai = ((g) * 2 + s) >> 2, m = ((g) * 2 + s) & 3; const size_t off = (size_t)(row0 + ai * HALF + m * 16) * D + col0; \
            _Pragma("unroll") for (int bj = 0; bj < 2; ++bj) _Pragma("unroll") for (int n = 0; n < 2; ++n) xg[buf][s][bj][n] = *(const f32x4*)(x + off + bj * HALF + n * 16); } } while (0)
        EZ_LD(0, 0);
#pragma unroll
        for (int g = 0; g < 4; ++g) {
            if (g + 1 < 4) EZ_LD((g + 1) & 1, g + 1);
            asm volatile("" : "+v"(xg[g & 1][0][0][0]), "+v"(xg[g & 1][0][0][1]), "+v"(xg[g & 1][0][1][0]), "+v"(xg[g & 1][0][1][1]), "+v"(xg[g & 1][1][0][0]), "+v"(xg[g & 1][1][0][1]), "+v"(xg[g & 1][1][1][0]), "+v"(xg[g & 1][1][1][1]));
#pragma unroll
            for (int s = 0; s < 2; ++s) { const int ai = (g * 2 + s) >> 2, m = (g * 2 + s) & 3; const size_t off = (size_t)(row0 + ai * HALF + m * 16) * D + col0;
#pragma unroll
                for (int bj = 0; bj < 2; ++bj)
#pragma unroll
                    for (int n = 0; n < 2; ++n) { const f32x4 zv = xg[g & 1][s][bj][n] * ALPHA + gv[bj][n] * acc[ai][bj][m][n];
                        u32x2 w; w.x = pkh(zv[0], zv[1]); w.y = pkh(zv[2], zv[3]); *(u32x2*)(Z + off + bj * HALF + n * 16) = w; } }
        }
#undef EZ_LD
    }
};
struct EpiSwiglu {
    static constexpr bool PERM = true;
    bf16_t* O; const float* b1; int wrs, ais;
    static constexpr int NDMA = 1;
    __device__ __forceinline__ const float* dma_base(const Unit& u, int) const { return b1 + (size_t)u.e * NW1 + u.pn * HALF; }
    __device__ __forceinline__ unsigned dma_off(int, int l) const { return (unsigned)(l < 32 ? 16 * l : 4 * DE + 16 * (l - 32)); }
    __device__ __forceinline__ void operator()(const f32x4 (&acc)[2][2][4][2], const Unit& u, int wr, int wc, int fr, int fq, const PG8_LAS float* lb) const {
        const int row0 = u.pm * BM + wr * wrs + fr, jc = u.pn * HALF + wc * 32 + 8 * fq;
        f32x4 bg[2], bl[2];
#pragma unroll
        for (int n = 0; n < 2; ++n) { bg[n] = *(const PG8_LAS f32x4*)(lb + wc * 32 + 8 * fq + 4 * n); bl[n] = *(const PG8_LAS f32x4*)(lb + HALF + wc * 32 + 8 * fq + 4 * n); }
#pragma unroll
        for (int ai = 0; ai < 2; ++ai)
#pragma unroll
            for (int m = 0; m < 4; ++m) { bf16_t* rowp = O + (size_t)(row0 + ai * ais + m * 16) * DE + jc;
                f32x4 o[2];
#pragma unroll
                for (int n = 0; n < 2; ++n) { const f32x4 g = acc[ai][0][m][n] + bg[n], l = acc[ai][1][m][n] + bl[n];
#pragma unroll
                    for (int j = 0; j < 4; ++j) { const float gg = fminf(g[j], 7.0f), ll = fminf(fmaxf(l[j], -7.0f), 7.0f);
                        const float sg = __builtin_amdgcn_rcpf(1.0f + __builtin_amdgcn_exp2f(gg * (-1.702f * LOG2E)));
                        o[n][j] = gg * sg * (ll + 1.0f); } }
                u32x4 w; w.x = r8h(pkh(o[0][0], o[0][1])); w.y = r8h(pkh(o[0][2], o[0][3])); w.z = r8h(pkh(o[1][0], o[1][1])); w.w = r8h(pkh(o[1][2], o[1][3]));
                if (wr * wrs + fr + ai * ais + m * 16 >= u.nv) w = (u32x4){0u, 0u, 0u, 0u};
                *(u32x4*)rowp = w; }
    }
};
struct EpiContrib {
    static constexpr bool PERM = true;
    bf16_t* O; const float* b2; const float* gate; int wrs, ais;
    static constexpr int NDMA = 2;
    __device__ __forceinline__ const float* dma_base(const Unit& u, int piece) const { return piece == 0 ? b2 + (size_t)u.e * D + u.pn * BM : gate + (size_t)u.pm * BM; }
    __device__ __forceinline__ unsigned dma_off(int, int l) const { return (unsigned)(16 * l); }
    __device__ __forceinline__ void operator()(const f32x4 (&acc)[2][2][4][2], const Unit& u, int wr, int wc, int fr, int fq, const PG8_LAS float* lb) const {
        const int row0 = u.pm * BM + wr * wrs + fr, col0 = u.pn * BM + wc * 32 + 8 * fq;
        f32x4 bv[2][2];
#pragma unroll
        for (int bj = 0; bj < 2; ++bj)
#pragma unroll
            for (int n = 0; n < 2; ++n) bv[bj][n] = *(const PG8_LAS f32x4*)(lb + bj * HALF + wc * 32 + 8 * fq + 4 * n);
        float gtv[2][4];
#pragma unroll
        for (int ai = 0; ai < 2; ++ai)
#pragma unroll
            for (int m = 0; m < 4; ++m) gtv[ai][m] = lb[256 + wr * wrs + fr + ai * ais + m * 16];
#pragma unroll
        for (int ai = 0; ai < 2; ++ai)
#pragma unroll
            for (int m = 0; m < 4; ++m) { const int row = row0 + ai * ais + m * 16; const float gt = gtv[ai][m]; bf16_t* rowp = O + (size_t)row * D + col0;
#pragma unroll
                for (int bj = 0; bj < 2; ++bj) { const f32x4 v0 = (acc[ai][bj][m][0] + bv[bj][0]) * gt, v1 = (acc[ai][bj][m][1] + bv[bj][1]) * gt;
                    u32x4 w; w.x = cvt_pk_bf16(v0[0], v0[1]); w.y = cvt_pk_bf16(v0[2], v0[3]); w.z = cvt_pk_bf16(v1[0], v1[1]); w.w = cvt_pk_bf16(v1[2], v1[3]);
                    if (gt != 0.f) *(u32x4*)(rowp + bj * HALF) = w; } }
    }
};

template <class Epi, class Sched, bool GATHER, bool HN = false>
__device__ __forceinline__ void gemm_phase(PG8_LAS unsigned char* lds, const Gemm g, const Sched& S, const Epi& E, const PG8_LAS unsigned* rowtab) {
    const int tid = threadIdx.x, wid = __builtin_amdgcn_readfirstlane(tid >> 6), lane = tid & 63, wr = wid >> 2, wc = wid & 3, fr = lane & 15, fq = lane >> 4;
    const int K = g.K, nt = K / BK;
    int rA[2]; unsigned cA2[2], voffB[2];
#pragma unroll
    for (int i = 0; i < 2; ++i) { int R, C; stage_rc(tid * 16 + i * 8192, R, C); const int Rb = Epi::PERM ? ((R & ~31) + perm32(R & 31)) : R;
        rA[i] = R; cA2[i] = (unsigned)C * 2u; voffB[i] = (unsigned)(Rb * K + C) * 2u; }
    const size_t kstep = (size_t)(BK * 2);
    const size_t hstep = HN ? (size_t)0 : (size_t)HALF * K * 2;
    const unsigned ldsw = (unsigned)wid * 1024u;
    const int aoff = lds_byte(wr * 64 + fr, fq * 8), boff = lds_byte(wc * 32 + fr, fq * 8);
#define PG8_SA(b, h) (((b) * 2 + (h)) * HTB)
#define PG8_SB(b, h) ((4 + (b) * 2 + (h)) * HTB)
#define PG8_STAGE(bufoff, gbase, voff) do { _Pragma("unroll") for (int _i = 0; _i < 2; ++_i) \
        __builtin_amdgcn_global_load_lds((const unsigned*)((const char*)(gbase) + (voff)[_i]), (PG8_LAS unsigned*)(lds + (bufoff) + ldsw + _i * 8192), 16, 0, 0); } while (0)
#define PG8_LDA(dst, b, h) do { _Pragma("unroll") for (int m = 0; m < 4; ++m) _Pragma("unroll") for (int k = 0; k < 2; ++k) dst[m][k] = *(const PG8_LAS bf16x8*)(lds + PG8_SA(b, h) + aoff + m * 2048 + k * 1024); } while (0)
#define PG8_LDB(dst, b, h) do { _Pragma("unroll") for (int n = 0; n < 2; ++n) _Pragma("unroll") for (int k = 0; k < 2; ++k) dst[n][k] = *(const PG8_LAS bf16x8*)(lds + PG8_SB(b, h) + boff + n * 2048 + k * 1024); } while (0)
#define PG8_MMA(ai, bj, At, Bt) do { __builtin_amdgcn_s_setprio(1); _Pragma("unroll") for (int m = 0; m < 4; ++m) _Pragma("unroll") for (int n = 0; n < 2; ++n) _Pragma("unroll") for (int k = 0; k < 2; ++k) \
        acc[ai][bj][m][n] = __builtin_amdgcn_mfma_f32_16x16x32_bf16(Bt[n][k], At[m][k], acc[ai][bj][m][n], 0, 0, 0); __builtin_amdgcn_s_setprio(0); } while (0)
#define PG8_WAIT_V(n) asm volatile("s_waitcnt vmcnt(" #n ")" ::: "memory")
#define PG8_WAIT_L(n) asm volatile("s_waitcnt lgkmcnt(" #n ")" ::: "memory")
#define PG8_BAR __builtin_amdgcn_s_barrier()
#define PG8_SCHED __builtin_amdgcn_sched_barrier(0)
#define PG8_AOFF(dst, un, uidx) do { _Pragma("unroll") for (int _h = 0; _h < 2; ++_h) _Pragma("unroll") for (int _i = 0; _i < 2; ++_i) \
        dst[_h][_i] = (GATHER ? rowtab[(uidx) * 256 + _h * HALF + rA[_i]] : (unsigned)((un).arow + _h * HALF + rA[_i]) * (unsigned)(K * 2)) + cA2[_i]; } while (0)
    Unit cur, nxt; int ui = 0;
    if (!S.next(0, cur)) return;
    f32x4 acc[2][2][4][2];
#pragma unroll
    for (int a = 0; a < 2; ++a)
#pragma unroll
        for (int b = 0; b < 2; ++b)
#pragma unroll
            for (int m = 0; m < 4; ++m)
#pragma unroll
                for (int n = 0; n < 2; ++n) acc[a][b][m][n] = (f32x4){0.f, 0.f, 0.f, 0.f};
    bf16x8 At[4][2], B0[2][2], B1[2][2];
    unsigned oA[2][2], oN[2][2];
    PG8_AOFF(oA, cur, 0);
#pragma unroll
    for (int h = 0; h < 2; ++h) { oN[h][0] = oA[h][0]; oN[h][1] = oA[h][1]; }
    const char* const gA = (const char*)g.A;
    const char* cB = (const char*)g.Bt + (size_t)cur.brow * K * 2;
    PG8_STAGE(PG8_SB(0, 0), cB, voffB); PG8_STAGE(PG8_SB(0, 1), cB + hstep, voffB); PG8_STAGE(PG8_SA(0, 0), gA, oA[0]); PG8_STAGE(PG8_SA(0, 1), gA, oA[1]);
    if (wr == 1) PG8_BAR;
    PG8_WAIT_V(2); PG8_BAR;
    PG8_STAGE(PG8_SB(1, 0), cB + kstep, voffB); PG8_STAGE(PG8_SA(1, 0), gA + kstep, oA[0]); PG8_STAGE(PG8_SB(1, 1), cB + hstep + kstep, voffB);
    PG8_WAIT_V(6); PG8_BAR;
    for (;;) {
        const bool has_next = S.next(ui + 1, nxt);
        const char* nB = has_next ? (const char*)g.Bt + (size_t)nxt.brow * K * 2 : cB;
        for (int t = 0; t < nt; t += 2) {
            const bool last = (t == nt - 2);
            if (last && has_next) PG8_AOFF(oN, nxt, ui + 1);
            const char* a1 = gA + (size_t)(t + 1) * kstep;
            const char* a2 = last ? gA : gA + (size_t)(t + 2) * kstep; const char* b2 = last ? nB : cB + (size_t)(t + 2) * kstep;
            const char* a3 = a2 + kstep; const char* b3 = b2 + kstep;
            unsigned o2[2][2];
#pragma unroll
            for (int h = 0; h < 2; ++h) { o2[h][0] = last ? oN[h][0] : oA[h][0]; o2[h][1] = last ? oN[h][1] : oA[h][1]; }
            PG8_LDB(B0, 0, 0); if (!HN) PG8_LDB(B1, 0, 1); PG8_SCHED; PG8_LDA(At, 0, 0); PG8_STAGE(PG8_SA(1, 1), a1, oA[1]);
            PG8_WAIT_V(8); PG8_WAIT_L(0); PG8_BAR; PG8_MMA(0, 0, At, B0); if (!HN) PG8_MMA(0, 1, At, B1); PG8_BAR; PG8_SCHED;
            PG8_LDA(At, 0, 1); PG8_STAGE(PG8_SB(0, 0), b2, voffB); PG8_STAGE(PG8_SB(0, 1), b2 + hstep, voffB); PG8_STAGE(PG8_SA(0, 0), a2, o2[0]);
            PG8_WAIT_V(8); PG8_WAIT_L(0); PG8_BAR; PG8_MMA(1, 0, At, B0); if (!HN) PG8_MMA(1, 1, At, B1); PG8_BAR; PG8_SCHED;
            PG8_LDB(B0, 1, 0); if (!HN) PG8_LDB(B1, 1, 1); PG8_SCHED; PG8_LDA(At, 1, 0); PG8_STAGE(PG8_SA(0, 1), a2, o2[1]);
            PG8_WAIT_V(8); PG8_WAIT_L(0); PG8_BAR; PG8_MMA(0, 0, At, B0); if (!HN) PG8_MMA(0, 1, At, B1); PG8_BAR; PG8_SCHED;
            PG8_LDA(At, 1, 1); PG8_STAGE(PG8_SB(1, 0), b3, voffB); PG8_STAGE(PG8_SB(1, 1), b3 + hstep, voffB); PG8_STAGE(PG8_SA(1, 0), a3, o2[0]);
            PG8_WAIT_V(8); PG8_WAIT_L(0); PG8_BAR; PG8_MMA(1, 0, At, B0); if (!HN) PG8_MMA(1, 1, At, B1); PG8_BAR; PG8_SCHED;
        }
        if (wr == 0) PG8_BAR;
        E(acc, cur, wr, wc, fr, fq);
        if (!has_next) break;
#pragma unroll
        for (int a = 0; a < 2; ++a)
#pragma unroll
            for (int b = 0; b < 2; ++b)
#pragma unroll
                for (int m = 0; m < 4; ++m)
#pragma unroll
                    for (int n = 0; n < 2; ++n) acc[a][b][m][n] = (f32x4){0.f, 0.f, 0.f, 0.f};
        cur = nxt; cB = nB; ++ui;
#pragma unroll
        for (int h = 0; h < 2; ++h) { oA[h][0] = oN[h][0]; oA[h][1] = oN[h][1]; }
        if (wr == 1) PG8_BAR;
    }
    PG8_WAIT_V(0);
    PG8_BAR;
#undef PG8_SA
#undef PG8_SB
#undef PG8_STAGE
#undef PG8_LDA
#undef PG8_LDB
#undef PG8_MMA
#undef PG8_WAIT_V
#undef PG8_WAIT_L
#undef PG8_BAR
#undef PG8_SCHED
#undef PG8_AOFF
}
}


namespace rg {
constexpr int A_BUF = 32768, BROW = 576, B_BUF = 64 * BROW, B_OFF = 2 * A_BUF, EPI_OFF = B_OFF + 2 * B_BUF, EPI_SLOT = 2048;
static_assert(EPI_OFF + 2 * EPI_SLOT <= 143360, "LDS");
template <class Epi, class Sched, bool G1, int ABL = 0>
__device__ __forceinline__ void moe_gemm(LAS unsigned char* lds, const Sched& S, const Epi& E, const bf16_t* A, const int* tok, const float* W, int N) {
    constexpr int K = 2048, nt = K / 64;
    const int tid = threadIdx.x, wid = __builtin_amdgcn_readfirstlane(tid >> 6), lane = tid & 63, wr = wid >> 2, wc = wid & 3, fr = lane & 15, fq = lane >> 4;
    const unsigned bwr = (unsigned)(8 * wid * BROW) + (unsigned)(8 * lane);
    const unsigned bsw = (unsigned)((wid & 1) << 3);
    const unsigned ard = (unsigned)((128 * wr + fr) * 128) + (unsigned)((fq ^ ((fr >> 1) & 7)) << 4);
    const unsigned brd = (unsigned)((8 * fq + (fr >> 2)) * BROW) + (unsigned)(((64 * wc + 16 * (fr & 3))) ^ ((fq & 1) << 3));
    const unsigned lds0 = (unsigned)(size_t)lds;
    const int rot = 0;
    pg8::Unit cur, nxt; int ui = 0;
    if (!S.next(0, cur)) return;
    f32x4 acc[2][2][4][2];
#pragma unroll
    for (int a = 0; a < 2; ++a)
#pragma unroll
        for (int b = 0; b < 2; ++b)
#pragma unroll
            for (int m = 0; m < 4; ++m)
#pragma unroll
                for (int n = 0; n < 2; ++n) acc[a][b][m][n] = (f32x4){0.f, 0.f, 0.f, 0.f};
    u32x2 sb[8], pk[8];
    unsigned ao[4], bo, tk[4]; __amdgpu_buffer_rsrc_t wrs_;
    const int* tokp = G1 ? tok : (const int*)A;
#define RG_SETUP(un) do { int l2 = lane; asm volatile("" : "+v"(l2)); _Pragma("unroll") for (int i = 0; i < 4; ++i) { const int R_ = 128 * wr + 8 * (wid & 3) + 32 * i + (l2 >> 3), C_ = ((l2 & 7) ^ ((R_ >> 1) & 7)) * 8; const int rr = (un).pm * 256 + R_; \
        ao[i] = ((unsigned)(G1 ? tok[rr] : rr) * (unsigned)K + (unsigned)C_) * 2u; } \
        const int c4 = 4 * l2; const int col = G1 ? ((c4 < 128) ? (un).pn * 128 + c4 : 2048 + (un).pn * 128 + (c4 - 128)) : (un).pn * 256 + c4; \
        bo = (unsigned)col * 4u; wrs_ = __builtin_amdgcn_make_buffer_rsrc((void*)(W + (size_t)(un).e * K * N), 0, K * N * 4, 0x00077FAC); } while (0)
#define RG_SETUP_PF(un) do { int l2 = lane; asm volatile("" : "+v"(l2)); _Pragma("unroll") for (int i = 0; i < 4; ++i) { const int R_ = 128 * wr + 8 * (wid & 3) + 32 * i + (l2 >> 3), C_ = ((l2 & 7) ^ ((R_ >> 1) & 7)) * 8; const int rr = (un).pm * 256 + R_; \
        ao[i] = ((unsigned)(G1 ? (int)tk[i] : rr) * (unsigned)K + (unsigned)C_) * 2u; } \
        const int c4 = 4 * l2; const int col = G1 ? ((c4 < 128) ? (un).pn * 128 + c4 : 2048 + (un).pn * 128 + (c4 - 128)) : (un).pn * 256 + c4; \
        bo = (unsigned)col * 4u; wrs_ = __builtin_amdgcn_make_buffer_rsrc((void*)(W + (size_t)(un).e * K * N), 0, K * N * 4, 0x00077FAC); } while (0)
#define RG_TOK_PF(un) do { int l2 = lane; asm volatile("" : "+v"(l2)); const unsigned of0_ = (unsigned)(((un).pm * 256 + 128 * wr + 8 * (wid & 3) + (l2 >> 3)) * 4); \
        asm volatile("global_load_dword %0, %4, %5\n\tglobal_load_dword %1, %4, %5 offset:128\n\tglobal_load_dword %2, %4, %5 offset:256\n\tglobal_load_dword %3, %4, %5 offset:384" \
                     : "=&v"(tk[0]), "=&v"(tk[1]), "=&v"(tk[2]), "=&v"(tk[3]) : "v"(of0_), "s"(tokp) : "memory"); } while (0)
#define RG_ISSUE_A(buf, kt) do { const char* ab_ = (const char*)A + (size_t)((ABL & 16) ? 0 : (((kt) + rot) & (nt - 1))) * 128; unsigned keep_; \
        const unsigned d0_ = (unsigned)__builtin_amdgcn_readfirstlane((int)(lds0 + (unsigned)((buf) * A_BUF + (128 * wr + 8 * (wid & 3)) * 128)));     \
        asm volatile("s_mov_b32 %0, m0\n\ts_mov_b32 m0, %5\n\ts_nop 0\n\tglobal_load_lds_dwordx4 %1, %6\n\ts_add_u32 m0, m0, 0x1000\n\ts_nop 0\n\tglobal_load_lds_dwordx4 %2, %6\n\t" \
                     "s_add_u32 m0, m0, 0x1000\n\ts_nop 0\n\tglobal_load_lds_dwordx4 %3, %6\n\ts_add_u32 m0, m0, 0x1000\n\ts_nop 0\n\tglobal_load_lds_dwordx4 %4, %6\n\ts_mov_b32 m0, %0" \
                     : "=&s"(keep_) : "v"(ao[0]), "v"(ao[1]), "v"(ao[2]), "v"(ao[3]), "s"(d0_), "s"(ab_) : "memory", "scc"); } while (0)
#define RG_ISSUE_B_TO(kt, DST) do { const unsigned r0_ = (unsigned)(((((kt) + rot) & (nt - 1)) * 64 + 8 * wid) * N) * 4u; const unsigned rs_ = (unsigned)N * 4u; \
        asm volatile("s_nop 4\n\tbuffer_load_format_d16_xyzw %0, %8, %9, %10 offen\n\tbuffer_load_format_d16_xyzw %1, %8, %9, %11 offen\n\tbuffer_load_format_d16_xyzw %2, %8, %9, %12 offen\n\tbuffer_load_format_d16_xyzw %3, %8, %9, %13 offen\n\t" \
                     "buffer_load_format_d16_xyzw %4, %8, %9, %14 offen\n\tbuffer_load_format_d16_xyzw %5, %8, %9, %15 offen\n\tbuffer_load_format_d16_xyzw %6, %8, %9, %16 offen\n\tbuffer_load_format_d16_xyzw %7, %8, %9, %17 offen" \
                     : "=&v"(DST[0]), "=&v"(DST[1]), "=&v"(DST[2]), "=&v"(DST[3]), "=&v"(DST[4]), "=&v"(DST[5]), "=&v"(DST[6]), "=&v"(DST[7]) \
                     : "v"(bo), "s"(wrs_), "s"(r0_), "s"(r0_ + rs_), "s"(r0_ + 2u * rs_), "s"(r0_ + 3u * rs_), "s"(r0_ + 4u * rs_), "s"(r0_ + 5u * rs_), "s"(r0_ + 6u * rs_), "s"(r0_ + 7u * rs_) : "memory"); } while (0)
#define RG_ISSUE_B(kt) RG_ISSUE_B_TO(kt, sb)
#define RG_WAIT_B() asm volatile("s_waitcnt vmcnt(4)" : "+v"(sb[0]), "+v"(sb[1]), "+v"(sb[2]), "+v"(sb[3]), "+v"(sb[4]), "+v"(sb[5]), "+v"(sb[6]), "+v"(sb[7]) :: "memory")
#define RG_CVT_B() do { _Pragma("unroll") for (int j = 0; j < 8; ++j) asm volatile("v_and_b32 %0, 0xfff8fff8, %2\n\tv_and_b32 %1, 0xfff8fff8, %3" : "=&v"(pk[j].x), "=&v"(pk[j].y) : "v"(sb[j].x), "v"(sb[j].y)); } while (0)
#define RG_STORE_B(buf) do { _Pragma("unroll") for (int j = 0; j < 8; ++j) *(LAS u32x2*)(lds + B_OFF + (buf) * B_BUF + (bwr ^ bsw) + j * BROW) = pk[j];     } while (0)
#define RG_LDA(dst, buf, ks, ai) do { _Pragma("unroll") for (int m = 0; m < 4; ++m) dst[m] = *(const LAS bf16x8*)(lds + (buf) * A_BUF + (ard ^ (unsigned)((ks) * 64)) + (ai) * 8192 + m * 2048); } while (0)
#define RG_LDB(dst, buf, ks) do { _Pragma("unroll") for (int bj = 0; bj < 2; ++bj) _Pragma("unroll") for (int n = 0; n < 2; ++n) { const LAS unsigned char* bp = lds + B_OFF + (buf) * B_BUF + (ks) * 32 * BROW + (brd ^ (unsigned)(n * 8)) + bj * 256; \
            const s16x4 t1 = ds_tr16(bp), t2 = ds_tr16(bp + 4 * BROW); dst[bj][n] = __builtin_shufflevector(t1, t2, 0, 1, 2, 3, 4, 5, 6, 7); } } while (0)
#define RG_MMA(ai, Af, Bf) do { _Pragma("unroll") for (int m = 0; m < 4; ++m) _Pragma("unroll") for (int bj = 0; bj < 2; ++bj) _Pragma("unroll") for (int n = 0; n < 2; ++n) \
            acc[ai][bj][m][n] = __builtin_amdgcn_mfma_f32_16x16x32_f16(__builtin_bit_cast(h16x8, Bf[bj][n]), __builtin_bit_cast(h16x8, Af[m]), acc[ai][bj][m][n], 0, 0, 0); } while (0)
#define RG_COMPUTE_HEAD(buf) do { \
        RG_LDB(Be, buf, 0); RG_LDA(Ae, buf, 0, 0); RG_LDA(Ao, buf, 0, 1); __builtin_amdgcn_sched_barrier(0); \
        RG_MMA(0, Ae, Be); __builtin_amdgcn_sched_barrier(0); \
        RG_LDB(Bo, buf, 1); RG_LDA(Ae, buf, 1, 0); __builtin_amdgcn_sched_barrier(0); \
        RG_MMA(1, Ao, Be); __builtin_amdgcn_sched_barrier(0); \
        RG_LDA(Ao, buf, 1, 1); __builtin_amdgcn_sched_barrier(0); \
        RG_MMA(0, Ae, Bo); __builtin_amdgcn_sched_barrier(0); } while (0)
#define RG_COMPUTE_TAIL() do { __builtin_amdgcn_sched_barrier(0); RG_MMA(1, Ao, Bo); __builtin_amdgcn_sched_barrier(0); } while (0)
#define RG_BAR() do { asm volatile("s_waitcnt lgkmcnt(0)" ::: "memory"); __builtin_amdgcn_s_barrier(); asm volatile("" ::: "memory"); } while (0)
#define RG_VM0() asm volatile("s_waitcnt vmcnt(0)" ::: "memory")
#define RG_ISSUE_EPI(un, slot) do { if (wid == 0) { int l3 = lane; asm volatile("" : "+v"(l3)); _Pragma("unroll") for (int pc = 0; pc < Epi::NDMA; ++pc) { unsigned keep_; const unsigned dst_ = (unsigned)__builtin_amdgcn_readfirstlane((int)(lds0 + (unsigned)(EPI_OFF + (slot) * EPI_SLOT + pc * 1024))); \
            asm volatile("s_mov_b32 %0, m0\n\ts_mov_b32 m0, %2\n\ts_nop 0\n\tglobal_load_lds_dwordx4 %1, %3\n\ts_mov_b32 m0, %0" : "=&s"(keep_) : "v"(E.dma_off(pc, l3)), "s"(dst_), "s"(E.dma_base(un, pc)) : "memory"); } } } while (0)
    RG_SETUP(cur);
    if (ABL == 0) RG_ISSUE_EPI(cur, 0);
    if (ABL & 2) { _Pragma("unroll") for (int j = 0; j < 8; ++j) { sb[j] = (u32x2){0u, 0u}; asm volatile("" : "+v"(sb[j])); } }
    if (ABL & 8) { _Pragma("unroll") for (int j = 0; j < 8; ++j) { pk[j] = (u32x2){0u, 0u}; asm volatile("" : "+v"(pk[j])); } }
    RG_ISSUE_A(0, 0); RG_ISSUE_B_TO(0, pk); RG_ISSUE_B_TO(1, sb);
    asm volatile("s_waitcnt vmcnt(0)" : "+v"(pk[0]), "+v"(pk[1]), "+v"(pk[2]), "+v"(pk[3]), "+v"(pk[4]), "+v"(pk[5]), "+v"(pk[6]), "+v"(pk[7]), "+v"(sb[0]), "+v"(sb[1]), "+v"(sb[2]), "+v"(sb[3]), "+v"(sb[4]), "+v"(sb[5]), "+v"(sb[6]), "+v"(sb[7]) :: "memory");
#pragma unroll
    for (int j = 0; j < 8; ++j) asm volatile("v_and_b32 %0, 0xfff8fff8, %0\n\tv_and_b32 %1, 0xfff8fff8, %1" : "+v"(pk[j].x), "+v"(pk[j].y));
    RG_STORE_B(0); RG_BAR();
    if (wr == 1) __builtin_amdgcn_s_barrier();
    int ntv = nt; asm volatile("" : "+s"(ntv));
    for (;;) {
        const bool has_next = S.next(ui + 1, nxt);
#pragma unroll 1
        for (int t = 0; t < ntv; ++t) {
            const int cb = t & 1;
            const bool last2 = (t + 2 >= ntv), last1 = (t + 1 >= ntv);
            const bool nexta = !last1 || has_next;
            const bool sw = last2 && !last1 && has_next;
            if (G1 && sw) RG_TOK_PF(nxt);
            if (nexta) { if (!(ABL & 4)) RG_ISSUE_A(cb ^ 1, (t + 1) & (nt - 1)); if (!(ABL & 2)) RG_WAIT_B(); if (!(ABL & 8)) RG_CVT_B(); } else RG_VM0();
            if (sw) { if (G1) asm volatile("" : "+v"(tk[0]), "+v"(tk[1]), "+v"(tk[2]), "+v"(tk[3])); RG_SETUP_PF(nxt); }
            if (!(ABL & 2)) if (!last2 || (has_next && !last1)) RG_ISSUE_B((t + 2) & (nt - 1));
            RG_BAR();
            if (nexta && !(ABL & 8)) RG_STORE_B(cb ^ 1);
            bf16x8 Ae[4], Ao[4], Be[2][2], Bo[2][2];
            if (!(ABL & 1)) RG_COMPUTE_HEAD(cb);
            RG_BAR();
            if (!(ABL & 1)) RG_COMPUTE_TAIL();
        }
        if (has_next && ABL == 0) { RG_ISSUE_B(1); RG_ISSUE_EPI(nxt, (ui + 1) & 1); }
        if (ABL == 0) E(acc, cur, wr, wc, fr, fq, (const LAS float*)(lds + EPI_OFF + (ui & 1) * EPI_SLOT));
        else { _Pragma("unroll") for (int a = 0; a < 2; ++a) _Pragma("unroll") for (int b = 0; b < 2; ++b) _Pragma("unroll") for (int m = 0; m < 4; ++m) asm volatile("" :: "v"(acc[a][b][m][0]), "v"(acc[a][b][m][1])); }
        if (!has_next) break;
        if (ABL != 0 && !(ABL & 2)) RG_ISSUE_B(1);
#pragma unroll
        for (int a = 0; a < 2; ++a)
#pragma unroll
            for (int b = 0; b < 2; ++b)
#pragma unroll
                for (int m = 0; m < 4; ++m)
#pragma unroll
                    for (int n = 0; n < 2; ++n) acc[a][b][m][n] = (f32x4){0.f, 0.f, 0.f, 0.f};
        cur = nxt; ++ui;
    }
    if (wr == 0) __builtin_amdgcn_s_barrier();
    RG_BAR();
#undef RG_SETUP
#undef RG_ISSUE_A
#undef RG_ISSUE_B
#undef RG_ISSUE_B_TO
#undef RG_WAIT_B
#undef RG_CVT_B
#undef RG_STORE_B
#undef RG_COMPUTE_HEAD
#undef RG_COMPUTE_TAIL
#undef RG_LDA
#undef RG_LDB
#undef RG_MMA
#undef RG_BAR
#undef RG_VM0
#undef RG_SETUP_PF
#undef RG_TOK_PF
#undef RG_ISSUE_EPI
}
}

#define XB_TMO      128
#define XB_XCNT(j)  (256  + 64 * (j))
#define XB_XSUB(j)  (1280 + 64 * (j))
#define XB_XGEN(j)  (2304 + 64 * (j))
#define XB_TOP      3328
#define XB_TOPGEN   3392
#define XCD_BAR_WORDS 3456
#define XB_SPIN_CAP (1u << 18)
__device__ __forceinline__ unsigned xb_ld(unsigned* p)              { return __hip_atomic_load(p, __ATOMIC_RELAXED, __HIP_MEMORY_SCOPE_AGENT); }
__device__ __forceinline__ unsigned xb_add(unsigned* p, unsigned v) { return __hip_atomic_fetch_add(p, v, __ATOMIC_RELAXED, __HIP_MEMORY_SCOPE_AGENT); }
__device__ __forceinline__ unsigned xb_xcc_id() { return (unsigned)__builtin_amdgcn_s_getreg((3 << 11) | 20) & 0xFu; }
#define XB_SPIN(cond, bar) do { unsigned _sp = 0; while (cond) { __builtin_amdgcn_s_sleep(1); \
    if ((++_sp & 255u) == 0u) { if (xb_ld(&(bar)[XB_TMO])) break; if (_sp > XB_SPIN_CAP) { atomicAdd(&(bar)[XB_TMO], 1u); break; } } } } while (0)
struct XcdBarrier { unsigned* bar; unsigned x; volatile LAS unsigned* st; };
__device__ __forceinline__ XcdBarrier xcd_barrier_post(unsigned* bar, volatile LAS unsigned* st) {
    XcdBarrier b; b.bar = bar; b.x = xb_xcc_id(); b.st = st;
    if (threadIdx.x == 0) (void)xb_add(&bar[XB_XCNT(b.x)], 1u);
    return b;
}
__device__ __forceinline__ void xcd_barrier_complete(unsigned* bar, unsigned x, unsigned& nloc, unsigned& nx) {
    const unsigned G = gridDim.x * gridDim.y * gridDim.z;
    unsigned sum, cnt, mine, sp = 0u;
    for (;;) {
        sum = 0u; cnt = 0u; mine = 0u;
#pragma unroll
        for (unsigned j = 0; j < 16; ++j) { const unsigned c = xb_ld(&bar[XB_XCNT(j)]); sum += c; cnt += (c > 0u) ? 1u : 0u; mine = (j == x) ? c : mine; }
        if (sum == G) break;
        __builtin_amdgcn_s_sleep(1);
        if ((++sp & 255u) == 0u) { if (xb_ld(&bar[XB_TMO])) break; if (sp > XB_SPIN_CAP) { atomicAdd(&bar[XB_TMO], 1u); break; } }
    }
    nloc = mine > 0u ? mine : 1u; nx = cnt > 0u ? cnt : 1u;
}
__device__ __forceinline__ void xcd_barrier(const XcdBarrier& b) {
    asm volatile("s_waitcnt vmcnt(0)" ::: "memory");
    __syncthreads();
    if (threadIdx.x == 0) {
        unsigned* bar = b.bar;
        __builtin_amdgcn_s_waitcnt(0);
        unsigned nloc = b.st[0], nx = b.st[1];
        if (nloc == 0u) { xcd_barrier_complete(bar, b.x, nloc, nx); b.st[0] = nloc; b.st[1] = nx; }
        const unsigned old = xb_add(&bar[XB_XSUB(b.x)], 1u);
        const unsigned gen = old / nloc;
        if (old + 1u == (gen + 1u) * nloc) {
            __builtin_amdgcn_fence(__ATOMIC_RELEASE, "agent");
            asm volatile("s_waitcnt vmcnt(0)" ::: "memory");
            const unsigned og = xb_add(&bar[XB_TOP], 1u);
            const unsigned tg = og / nx;
            if (og + 1u == (tg + 1u) * nx) xb_add(&bar[XB_TOPGEN], 1u);
            else XB_SPIN(xb_ld(&bar[XB_TOPGEN]) == tg, bar);
            __builtin_amdgcn_fence(__ATOMIC_ACQUIRE, "agent");
            xb_add(&bar[XB_XGEN(b.x)], 1u);
            asm volatile("s_waitcnt vmcnt(0)" ::: "memory");
        } else {
            XB_SPIN(xb_ld(&bar[XB_XGEN(b.x)]) == gen, bar);
            __builtin_amdgcn_fence(__ATOMIC_ACQUIRE, "agent");
            asm volatile("s_waitcnt vmcnt(0)" ::: "memory");
        }
    }
    __syncthreads();
}

constexpr int NPH = 11;
struct Args { const float* in[20]; float* out; unsigned char* ws; int ph_lo, ph_hi, li, pad; };

__device__ __forceinline__ void transpose_item(const float* W, int K, int N, bf16_t* WT, int k0, int n0, int drow, LAS float* scr, int lane) {
#pragma unroll 8
    for (int i = 0; i < 32; ++i) { const int kk = 2 * i + (lane >> 5); scr[kk * 33 + (lane & 31)] = W[(size_t)(k0 + kk) * N + n0 + (lane & 31)]; }
    LDS_WAIT(); asm volatile("" ::: "memory");
    const int c = lane & 7;
#pragma unroll
    for (int j = 0; j < 4; ++j) { const int n = (lane >> 3) + 8 * j; const LAS float* s = scr + (8 * c) * 33 + n;
        u32x4 o; o.x = pk2(s[0 * 33], s[1 * 33]); o.y = pk2(s[2 * 33], s[3 * 33]); o.z = pk2(s[4 * 33], s[5 * 33]); o.w = pk2(s[6 * 33], s[7 * 33]);
        *(GAS u32x4*)(WT + (size_t)(drow + n) * K + k0 + 8 * c) = o; }
    LDS_WAIT(); asm volatile("" ::: "memory");
}

__global__ void __launch_bounds__(NTHR, 2) fwd_kernel(Args args) {
    extern __shared__ __attribute__((aligned(16))) unsigned char lds_raw[];
    LAS unsigned char* lds = (LAS unsigned char*)lds_raw;
    volatile LAS unsigned* MISC = (volatile LAS unsigned*)(lds + MISC_OFF);
    const int tid = threadIdx.x, lane = tid & 63, wave = __builtin_amdgcn_readfirstlane(tid >> 6);
    const int G = gridDim.x, bx = blockIdx.x;
    unsigned char* ws = args.ws;
    gu32* ctl = (gu32*)(ws + WS_CTL);
    const float* x = args.in[0]; const float* cvec = args.in[1]; const float* w_ada = args.in[2]; const float* b_ada = args.in[3]; const float* w_in = args.in[4];
    const float* sgu_g = args.in[5]; const float* sgu_b = args.in[6]; const float* w_sp = args.in[7]; const float* b_sp = args.in[8]; const float* w_o = args.in[9];
    const float* ln1_g = args.in[10]; const float* ln1_b = args.in[11]; const float* w_router = args.in[12]; const float* b_router = args.in[13];
    const float* w_e1 = args.in[14]; const float* b_e1 = args.in[15]; const float* w_e2 = args.in[16]; const float* b_e2 = args.in[17]; const float* ln2_g = args.in[18]; const float* ln2_b = args.in[19];
    float* out = args.out;
    float* PADA = (float*)(ws + WS_PADA);
    float* WRT = (float*)(ws + WS_PADA + MiB + 512 * 1024);
    float* ADA = (float*)(ws + WS_PADA + MiB);
    bf16_t* WINT = (bf16_t*)(ws + WS_WIN); bf16_t* WOT = (bf16_t*)(ws + WS_WO);
    bf16_t* H = (bf16_t*)(ws + WS_H); bf16_t* PROJ = (bf16_t*)(ws + WS_PROJ); bf16_t* OB = (bf16_t*)(ws + WS_OB); bf16_t* Y = (bf16_t*)(ws + WS_Y);
    bf16_t* Z = (bf16_t*)(ws + WS_Z); bf16_t* X1 = (bf16_t*)(ws + WS_X1);   bf16_t* H2 = (bf16_t*)(ws + WS_H2); bf16_t* ACT = (bf16_t*)(ws + WS_ACT); bf16_t* CONTRIB = (bf16_t*)(ws + WS_CONTRIB);
    int* TOPI = (int*)(ws + WS_SMALL + SM_TOPI); float* TOPG = (float*)(ws + WS_SMALL + SM_TOPG); int* RBC = (int*)(ws + WS_SMALL + SM_RBC);
    int* TOK = (int*)(ws + WS_SMALL + SM_TOK); float* GATEP = (float*)(ws + WS_SMALL + SM_GATEP); int* POSOF = (int*)(ws + WS_SMALL + SM_POSOF);
    int* TEXP = (int*)(ws + WS_SMALL + SM_TEXP);
    float* LSE = (float*)(ws + WS_SMALL + SM_LSE);

    for (int u = tid; u < (LDS_BYTES - MISC_OFF) / 4; u += NTHR) ((LAS unsigned*)(lds + MISC_OFF))[u] = 0u;
    __syncthreads();
    constexpr bool ONE = (MK_N_LAUNCHES == 1);
    XcdBarrier bar; bar.bar = (unsigned*)(ctl + CW_BAR); bar.x = 0; bar.st = nullptr;
    if (ONE) bar = xcd_barrier_post((unsigned*)(ctl + CW_BAR), MISC + 8);
#define GRID_BAR() do { if (ONE) xcd_barrier(bar); } while (0)
    const int lo = args.ph_lo, hi = args.ph_hi;
#ifndef MK_PH_MASK
#define MK_PH_MASK 0x7ff
#endif
#define IN(k) ((((MK_PH_MASK) >> (k)) & 1) && lo <= (k) && (k) < hi)
#define BOTH(k) (IN(k) && IN((k) + 1))
    const int gtid = bx * NTHR + tid, GT = G * NTHR, gw = bx * NWAVES + wave, NGW = G * NWAVES;

    if (IN(0)) { for (int rep = 0; rep < NREP(0); ++rep) {
        LAS float* red = (LAS float*)lds;
#define ADA_ITEM(ks_, ns_) do { const int col_ = (ns_) * 256 + lane * 4; f32x4 a_ = (f32x4){0.f, 0.f, 0.f, 0.f}; \
            _Pragma("unroll 4") for (int r = 0; r < 16; ++r) { const int k = (ks_) * 128 + wave * 16 + r; const float cv = cvec[k]; const float sv = cv / (1.0f + __expf(-cv)); \
                a_ += *(const f32x4*)(w_ada + (size_t)k * (6 * D) + col_) * sv; } \
            _Pragma("unroll") for (int j = 0; j < 4; ++j) red[wave * 256 + lane * 4 + j] = a_[j]; \
            __syncthreads(); \
            if (tid < 256) { float s_ = 0.f; _Pragma("unroll") for (int w = 0; w < 8; ++w) s_ += red[w * 256 + tid]; PADA[(ks_) * (6 * D) + (ns_) * 256 + tid] = s_; } \
            __syncthreads(); } while (0)
        for (int it = bx; it < 16 * 16 && rep == 0; it += G) ADA_ITEM(it / 16, it % 16);
        LAS float* scr = (LAS float*)(lds + wave * 16384);
        constexpr int I_IN = 32 * (NPROJ / 32);
        for (int it = gw; it < I_IN; it += NGW) { const int nblk = NPROJ / 32, kb = it / nblk, nb = it % nblk; transpose_item(w_in, D, NPROJ, WINT, 64 * kb, 32 * nb, 32 * nb, scr, lane); }
        if (BOTH(0) || rep + 1 < NREP(0)) GRID_BAR();
    } }

    if (IN(1)) { for (int rep = 0; rep < NREP(1); ++rep) {
        LAS float* ssl = (LAS float*)lds;
        for (int j = tid; j < 2 * D; j += NTHR) { float s = b_ada[j];
#pragma unroll
            for (int q = 0; q < 16; ++q) s += PADA[q * (6 * D) + j];
            ssl[j] = s; }
        __syncthreads();
        { const int col = (gtid % (D / 4)) * 4;
          const f32x4 sh = *(const LAS f32x4*)(ssl + col), sc1 = *(const LAS f32x4*)(ssl + D + col) + 1.0f;
          for (int i0 = gtid; i0 < S * (D / 4); i0 += 8 * GT) {
              f32x4 xv[8];
#pragma unroll
              for (int u = 0; u < 8; ++u) { const int i = i0 + u * GT; xv[u] = (i < S * (D / 4)) ? *(const f32x4*)(x + (size_t)i * 4) : (f32x4){0.f, 0.f, 0.f, 0.f}; }
#pragma unroll
              for (int u = 0; u < 8; ++u) { const int i = i0 + u * GT; const f32x4 hv = xv[u] * sc1 + sh;
                  u32x2 w; w.x = pk2(hv[0], hv[1]); w.y = pk2(hv[2], hv[3]);
                  if (i < S * (D / 4)) *(u32x2*)(H + (size_t)i * 4) = w; }
          } }
        __syncthreads();
        if (BOTH(1) || rep + 1 < NREP(1)) GRID_BAR();
    } }

    if (IN(2)) { for (int rep = 0; rep < NREP(2); ++rep) {
        pg8::Gemm g{H, WINT, D}; pg8::EpiProj E{PROJ};
        constexpr int NU = (S / 256) * (NPROJ / 256);
        pg8::DenseOrder So{S / 256, NPROJ / 256, G, bx, NU};
        pg8::gemm_phase<pg8::EpiProj, pg8::DenseOrder, false>(lds, g, So, E, nullptr);
        if (rep == 0) {
            const int first = NU % G, nidle = G - first, w = bx - first;
            if (w >= 0) {
                LAS float* red = (LAS float*)lds;
                for (int it = w; it < 16 * 32; it += nidle) ADA_ITEM(it / 32, 16 + it % 32);
                constexpr int I_O = 32 * (D / 32), I_TOK = CAP / 1024, I_WRT = NE * D / 1024, NFILL = I_O + I_TOK + I_WRT + 1;
                LAS float* scr = (LAS float*)(lds + wave * 16384);
                for (int it0 = w * 8 + wave; it0 < NFILL; it0 += nidle * 8) { int it = it0;
                    if (it < I_O) { const int nblk = D / 32, kb = it / nblk, nb = it % nblk; transpose_item(w_o, D, D, WOT, 64 * kb, 32 * nb, 32 * nb, scr, lane); continue; }
                    it -= I_O;
                    if (it < I_TOK) { for (int i = it * 1024 + lane; i < it * 1024 + 1024; i += 64) { TOK[i] = S; GATEP[i] = 0.f; } continue; }
                    it -= I_TOK;
                    if (it < I_WRT) { for (int i = it * 1024 + lane; i < it * 1024 + 1024; i += 64) WRT[i] = w_router[(size_t)(i & (D - 1)) * NE + (i >> 11)]; continue; }
                    for (int i = lane; i < D / 2; i += 64) ((unsigned*)(H2 + (size_t)S * D))[i] = 0u;
                }
            }
        }
#undef ADA_ITEM
        if (BOTH(2) || rep + 1 < NREP(2)) GRID_BAR();
    } }

    if (IN(3)) { for (int rep = 0; rep < NREP(3); ++rep) {
        for (int j = 2 * D + gtid; j < 6 * D; j += GT) { float s = b_ada[j];
#pragma unroll
            for (int q = 0; q < 16; ++q) s += PADA[q * (6 * D) + j];
            ADA[j] = s; }
        const int fr = lane & 15, fq = lane >> 4;
        const int vcu = (G % 8 == 0) ? (bx % 8) * (G / 8) + bx / 8 : bx;
        for (int uk = 0; uk * G + vcu < 2048; ++uk) {
            const int uu = (G == 256) ? ((((uk + (vcu >> 5)) & 7) << 8) + vcu) : uk * G + vcu;
            if (uu >= 1536) {
                const int q = uu - 1536, n = q >> 3, g = q & 7;
                LAS unsigned char* vh = lds;
                unsigned pkv[16];
#pragma unroll
                for (int rr = 0; rr < 16; ++rr) pkv[rr] = *(const unsigned*)(PROJ + (size_t)(n * 128 + wave * 16 + rr) * NPROJ + DG + g * 128 + 2 * lane);
                const int t = wave * 16 + fr;
                const float* wrow = w_sp + ((size_t)g * 128 + t) * 128;
                f32x4 w0v[4], w1v[4]; u32x2 ug[8];
#pragma unroll
                for (int ks = 0; ks < 4; ++ks) { w0v[ks] = *(const f32x4*)(wrow + 32 * ks + 4 * fq); w1v[ks] = *(const f32x4*)(wrow + 32 * ks + 4 * fq + 16); }
#pragma unroll
                for (int ct = 0; ct < 8; ++ct) ug[ct] = *(const u32x2*)(PROJ + (size_t)(n * 128 + t) * NPROJ + g * 128 + 16 * ct + 4 * fq);
                float bias = b_sp[g * 128 + t];
                asm volatile("" : "+v"(w0v[0]), "+v"(w0v[1]), "+v"(w0v[2]), "+v"(w0v[3]), "+v"(w1v[0]), "+v"(w1v[1]), "+v"(w1v[2]), "+v"(w1v[3]), "+v"(ug[0]), "+v"(ug[1]), "+v"(ug[2]), "+v"(ug[3]),
                             "+v"(ug[4]), "+v"(ug[5]), "+v"(ug[6]), "+v"(ug[7]), "+v"(bias) :: "memory");
#pragma unroll
                for (int rr = 0; rr < 16; ++rr) {
                    const int s = wave * 16 + rr;
                    const unsigned pk = pkv[rr];
                    const float a = bflo(pk), b = bfhi(pk);
                    const float mean = wave_sum(a + b) * (1.0f / 128.0f);
                    const float da = a - mean, db = b - mean;
                    const float var = wave_sum(da * da + db * db) * (1.0f / 128.0f);
                    const float rstd = __builtin_amdgcn_rsqf(var + LN_EPS);
                    const int c = g * 128 + 2 * lane;
                    *(LAS unsigned*)(vh + s * 288 + lane * 4) = pk2(da * rstd * sgu_g[c] + sgu_b[c], db * rstd * sgu_g[c + 1] + sgu_b[c + 1]);
                }
                __syncthreads();
                f32x4 acc[8];
#pragma unroll
                for (int ct = 0; ct < 8; ++ct) acc[ct] = (f32x4){0.f, 0.f, 0.f, 0.f};
                const int nks = (wave >> 1) + 1;
#pragma unroll
                for (int ks = 0; ks < 4; ++ks) { if (ks >= nks) break;
                    const int s0 = 32 * ks + 4 * fq, s1 = s0 + 16;
                    f32x4 w0 = w0v[ks], w1 = w1v[ks];
#pragma unroll
                    for (int j = 0; j < 4; ++j) { if (s0 + j > t) w0[j] = 0.f; if (s1 + j > t) w1[j] = 0.f; }
                    u32x4 wb; wb.x = pg8::cvt_pk_bf16(w0[0], w0[1]); wb.y = pg8::cvt_pk_bf16(w0[2], w0[3]); wb.z = pg8::cvt_pk_bf16(w1[0], w1[1]); wb.w = pg8::cvt_pk_bf16(w1[2], w1[3]);
                    const bf16x8 bfrag = __builtin_bit_cast(bf16x8, wb);
                    const LAS unsigned char* vb = vh + (32 * ks + 4 * fq + (fr >> 2)) * 288 + (fr & 3) * 8;
                    bf16x8 vfr[8];
#pragma unroll
                    for (int ct = 0; ct < 8; ++ct) { const s16x4 t1 = ds_tr16(vb + ct * 32), t2 = ds_tr16(vb + ct * 32 + 16 * 288); vfr[ct] = __builtin_bit_cast(bf16x8, __builtin_shufflevector(t1, t2, 0, 1, 2, 3, 4, 5, 6, 7)); }
                    asm volatile("" : "+v"(vfr[0]), "+v"(vfr[1]), "+v"(vfr[2]), "+v"(vfr[3]), "+v"(vfr[4]), "+v"(vfr[5]), "+v"(vfr[6]), "+v"(vfr[7]));
#pragma unroll
                    for (int ct = 0; ct < 8; ++ct) acc[ct] = __builtin_amdgcn_mfma_f32_16x16x32_bf16(vfr[ct], bfrag, acc[ct], 0, 0, 0);
                }
                { const size_t row = (size_t)(n * 128 + t);
#pragma unroll
                  for (int ct = 0; ct < 8; ++ct) { const int c = g * 128 + 16 * ct + 4 * fq;
                      const u32x2 uu2 = ug[ct];
                      u32x2 o; o.x = pk2(bflo(uu2.x) * (acc[ct][0] + bias), bfhi(uu2.x) * (acc[ct][1] + bias)); o.y = pk2(bflo(uu2.y) * (acc[ct][2] + bias), bfhi(uu2.y) * (acc[ct][3] + bias));
                      *(u32x2*)(Y + row * D + c) = o; } }
                __syncthreads();
            } else {
                const int b = uu >> 9, rem = uu & 511, h = rem >> 6, idx = rem & 63;
                const int dil = b == 0 ? 1 : (b == 1 ? 4 : 16), nb = 64 / dil, r = idx / nb, n = idx % nb;
                LAS unsigned char* Ks = lds;
                LAS unsigned char* Vs = lds + 65536;
                const int i = wave * 16 + fr; const size_t qpos = (size_t)(n * 128 + i) * dil + r;
                bf16x8 qf[4];
#pragma unroll
                for (int ks = 0; ks < 4; ++ks) qf[ks] = *(const bf16x8*)(PROJ + qpos * NPROJ + 2048 + h * 128 + 32 * ks + 8 * fq);
                { u32x4 kq[8], vq[8];
#pragma unroll
                  for (int j = 0; j < 8; ++j) { const int id = tid + NTHR * j, key = id >> 4, ch = id & 15, kj = (n - 1) * 128 + key;
                      const size_t pos = (size_t)(kj >= 0 ? kj : kj + 128) * dil + r; const bf16_t* pr = PROJ + pos * NPROJ + h * 128 + ch * 8;
                      kq[j] = *(const u32x4*)(pr + 3072); vq[j] = *(const u32x4*)(pr + 4096); }
                  asm volatile("" : "+v"(kq[0]), "+v"(kq[1]), "+v"(kq[2]), "+v"(kq[3]), "+v"(kq[4]), "+v"(kq[5]), "+v"(kq[6]), "+v"(kq[7]), "+v"(vq[0]), "+v"(vq[1]), "+v"(vq[2]), "+v"(vq[3]), "+v"(vq[4]), "+v"(vq[5]), "+v"(vq[6]), "+v"(vq[7]));
#pragma unroll
                  for (int j = 0; j < 8; ++j) { const int id = tid + NTHR * j, key = id >> 4, ch = id & 15, kj = (n - 1) * 128 + key;
                      u32x4 kv = kq[j], vv = vq[j];
                      if (kj < 0) { kv = (u32x4){0u, 0u, 0u, 0u}; vv = (u32x4){0u, 0u, 0u, 0u}; }
                      *(LAS u32x4*)(Ks + key * 256 + ((ch ^ (key & 15)) << 4)) = kv; *(LAS u32x4*)(Vs + key * 288 + ch * 16) = vv; } }
                __syncthreads();
                const int T0 = wave & ~1;
                f32x4 sa[10];
#pragma unroll
                for (int t = 0; t < 10; ++t) sa[t] = (f32x4){0.f, 0.f, 0.f, 0.f};
                { bf16x8 kf[2][2][4];
#define ATT_LDK(buf, grp) do { _Pragma("unroll") for (int tt = 0; tt < 2; ++tt) _Pragma("unroll") for (int ks = 0; ks < 4; ++ks) \
                        kf[buf][tt][ks] = *(const LAS bf16x8*)(Ks + (16 * (T0 + 2 * (grp) + tt) + fr) * 256 + (((4 * ks + fq) ^ fr) << 4)); } while (0)
                  ATT_LDK(0, 0);
#pragma unroll
                  for (int grp = 0; grp < 5; ++grp) {
                      if (grp + 1 < 5) ATT_LDK((grp + 1) & 1, grp + 1);
                      asm volatile("" : "+v"(kf[grp & 1][0][0]), "+v"(kf[grp & 1][0][1]), "+v"(kf[grp & 1][0][2]), "+v"(kf[grp & 1][0][3]), "+v"(kf[grp & 1][1][0]), "+v"(kf[grp & 1][1][1]), "+v"(kf[grp & 1][1][2]), "+v"(kf[grp & 1][1][3]));
#pragma unroll
                      for (int ks = 0; ks < 4; ++ks)
#pragma unroll
                          for (int tt = 0; tt < 2; ++tt) sa[2 * grp + tt] = __builtin_amdgcn_mfma_f32_16x16x32_bf16(kf[grp & 1][tt][ks], qf[ks], sa[2 * grp + tt], 0, 0, 0);
                  }
#undef ATT_LDK
                }
                const float slope2 = exp2f(-(float)(h + 1)) * LOG2E * (float)dil;
                float mx = -1e30f;
#pragma unroll
                for (int t = 0; t < 10; ++t)
#pragma unroll
                    for (int rg = 0; rg < 4; ++rg) { const int ki = 16 * (T0 + t) + 4 * fq + rg, j = ki - i;
                        const bool valid = (j >= 0) && (j <= 128) && (n > 0 || ki >= 128);
                        const float sv = valid ? sa[t][rg] - slope2 * (float)(128 - j) : -1e30f;
                        sa[t][rg] = sv; mx = fmaxf(mx, sv); }
                mx = fmaxf(mx, __shfl_xor(mx, 16)); mx = fmaxf(mx, __shfl_xor(mx, 32));
                float sum = 0.f;
#pragma unroll
                for (int t = 0; t < 10; ++t)
#pragma unroll
                    for (int rg = 0; rg < 4; ++rg) { const float p = __builtin_amdgcn_exp2f(sa[t][rg] - mx); sa[t][rg] = p; sum += p; }
                sum += __shfl_xor(sum, 16); sum += __shfl_xor(sum, 32);
                f32x4 oa[8];
#pragma unroll
                for (int ht = 0; ht < 8; ++ht) oa[ht] = (f32x4){0.f, 0.f, 0.f, 0.f};
                { bf16x8 vf[2][8];
#define ATT_LDV(buf, kk_) do { const LAS unsigned char* vb = Vs + (16 * (T0 + 2 * (kk_)) + 4 * fq + (fr >> 2)) * 288 + (fr & 3) * 8; \
                        _Pragma("unroll") for (int ht = 0; ht < 8; ++ht) { const s16x4 t1 = ds_tr16(vb + ht * 32), t2 = ds_tr16(vb + ht * 32 + 16 * 288); \
                            vf[buf][ht] = __builtin_bit_cast(bf16x8, __builtin_shufflevector(t1, t2, 0, 1, 2, 3, 4, 5, 6, 7)); } } while (0)
                  ATT_LDV(0, 0);
#pragma unroll
                  for (int kk = 0; kk < 5; ++kk) {
                      if (kk + 1 < 5) ATT_LDV((kk + 1) & 1, kk + 1);
                      asm volatile("" : "+v"(vf[kk & 1][0]), "+v"(vf[kk & 1][1]), "+v"(vf[kk & 1][2]), "+v"(vf[kk & 1][3]), "+v"(vf[kk & 1][4]), "+v"(vf[kk & 1][5]), "+v"(vf[kk & 1][6]), "+v"(vf[kk & 1][7]));
                      u32x4 pw; pw.x = pg8::cvt_pk_bf16(sa[2 * kk][0], sa[2 * kk][1]); pw.y = pg8::cvt_pk_bf16(sa[2 * kk][2], sa[2 * kk][3]);
                      pw.z = pg8::cvt_pk_bf16(sa[2 * kk + 1][0], sa[2 * kk + 1][1]); pw.w = pg8::cvt_pk_bf16(sa[2 * kk + 1][2], sa[2 * kk + 1][3]);
                      const bf16x8 pf = __builtin_bit_cast(bf16x8, pw);
#pragma unroll
                      for (int ht = 0; ht < 8; ++ht) oa[ht] = __builtin_amdgcn_mfma_f32_16x16x32_bf16(vf[kk & 1][ht], pf, oa[ht], 0, 0, 0);
                  }
#undef ATT_LDV
                }
                const float inv = 1.0f / sum;
                bf16_t* orow = OB + ((size_t)b * S + qpos) * DG + h * 128 + 4 * fq;
#pragma unroll
                for (int ht = 0; ht < 8; ++ht) { u32x2 o; o.x = pg8::cvt_pk_bf16(oa[ht][0] * inv, oa[ht][1] * inv); o.y = pg8::cvt_pk_bf16(oa[ht][2] * inv, oa[ht][3] * inv); *(u32x2*)(orow + 16 * ht) = o; }
                if (fq == 0) LSE[((size_t)b * S + qpos) * 8 + h] = mx + log2f(sum);
                __syncthreads();
            }
        }
        if (BOTH(3) || rep + 1 < NREP(3)) GRID_BAR();
    } }

    if (IN(4)) { for (int rep = 0; rep < NREP(4); ++rep) {
        for (int i0 = gtid; i0 < S * (DG / 8); i0 += 4 * GT) {
            u32x4 ob[4][3]; float ls[4][3];
#pragma unroll
            for (int u = 0; u < 4; ++u) { const int i = i0 + u * GT; const bool ok = i < S * (DG / 8); const int row = ok ? i / (DG / 8) : 0, col = ok ? (i % (DG / 8)) * 8 : 0, h = col >> 7;
#pragma unroll
                for (int b = 0; b < 3; ++b) { ob[u][b] = *(const u32x4*)(OB + ((size_t)b * S + row) * DG + col); ls[u][b] = LSE[((size_t)b * S + row) * 8 + h]; } }
#pragma unroll
            for (int u = 0; u < 4; ++u) { const int i = i0 + u * GT; if (i >= S * (DG / 8)) continue; const int row = i / (DG / 8), col = (i % (DG / 8)) * 8;
                const float l0 = ls[u][0], l1 = ls[u][1], l2 = ls[u][2];
                const float mx = fmaxf(fmaxf(l0, l1), l2);
                const float w0 = exp2f(l0 - mx), w1 = exp2f(l1 - mx), w2 = exp2f(l2 - mx), inv = 1.0f / (w0 + w1 + w2);
                u32x4 o;
#pragma unroll
                for (int q = 0; q < 4; ++q) { const unsigned o0 = ob[u][0][q], o1 = ob[u][1][q], o2 = ob[u][2][q];
                    const float ya = (w0 * bflo(o0) + w1 * bflo(o1) + w2 * bflo(o2)) * inv, yb = (w0 * bfhi(o0) + w1 * bfhi(o1) + w2 * bfhi(o2)) * inv;
                    o[q] = pk2(ya, yb); }
                *(u32x4*)(Y + (size_t)row * D + DG + col) = o; }
        }
        if (BOTH(4) || rep + 1 < NREP(4)) GRID_BAR();
    } }

    if (IN(5)) { for (int rep = 0; rep < NREP(5); ++rep) {
        pg8::Gemm g{Y, WOT, D}; pg8::DenseOrder So{S / 256, D / 256, G, bx, (S / 256) * (D / 256)}; pg8::EpiZ E{Z, x, ADA};
        pg8::gemm_phase<pg8::EpiZ, pg8::DenseOrder, false>(lds, g, So, E, nullptr);
        if (BOTH(5) || rep + 1 < NREP(5)) GRID_BAR();
    } }

    if (IN(6)) { for (int rep = 0; rep < NREP(6); ++rep) {
        constexpr int HS = D + 4;
        LAS float* h2f = (LAS float*)lds;
        for (int rb = bx; rb < S / 16; rb += G) {
            u32x2 zq[2][8];
            { unsigned lo = (unsigned)lane * 16u; asm volatile("" : "+v"(lo));
#pragma unroll
              for (int rr = 0; rr < 2; ++rr)
#pragma unroll
                  for (int j = 0; j < 8; ++j) zq[rr][j] = ldu2(Z + ((size_t)rb * 16 + wave * 2 + rr) * D, (lo + (unsigned)(j * 1024)) >> 1); }
            f32x4 lg[8], lb[8], lsh[8], lsc[8];
            { unsigned lo = (unsigned)lane * 16u; asm volatile("" : "+v"(lo));
#pragma unroll
              for (int j = 0; j < 8; ++j) { const unsigned of = lo + (unsigned)(j * 1024); lg[j] = ldf4(ln1_g, of); lb[j] = ldf4(ln1_b, of); lsh[j] = ldf4(ADA + 3 * D, of); lsc[j] = ldf4(ADA + 4 * D, of); } }
            { asm volatile("" : "+v"(zq[0][0]), "+v"(zq[0][1]), "+v"(zq[0][2]), "+v"(zq[0][3]), "+v"(zq[0][4]), "+v"(zq[0][5]), "+v"(zq[0][6]), "+v"(zq[0][7]),
                           "+v"(zq[1][0]), "+v"(zq[1][1]), "+v"(zq[1][2]), "+v"(zq[1][3]), "+v"(zq[1][4]), "+v"(zq[1][5]), "+v"(zq[1][6]), "+v"(zq[1][7]) :: "memory"); }
#pragma unroll
            for (int rr = 0; rr < 2; ++rr) {
                const int lr = wave * 2 + rr; const size_t row = (size_t)rb * 16 + lr;
                bf16_t* x1r = X1 + row * D; bf16_t* h2r = H2 + row * D;
                unsigned lo16 = (unsigned)lane * 16u; asm volatile("" : "+v"(lo16));
                f32x4 v[8]; float s = 0.f;
#pragma unroll
                for (int j = 0; j < 8; ++j) { v[j] = uph4(zq[rr][j]); s += (v[j][0] + v[j][1]) + (v[j][2] + v[j][3]); }
                const float mean = wave_sum(s) * (1.0f / D); float s2 = 0.f;
#pragma unroll
                for (int j = 0; j < 8; ++j) { v[j] = v[j] - mean; s2 += (v[j][0] * v[j][0] + v[j][1] * v[j][1]) + (v[j][2] * v[j][2] + v[j][3] * v[j][3]); }
                const float rstd = 1.0f / sqrtf(wave_sum(s2) * (1.0f / D) + LN_EPS);
#pragma unroll
                for (int j = 0; j < 8; ++j) { const unsigned of = lo16 + (unsigned)(j * 1024);
                    const f32x4 x1 = v[j] * rstd * lg[j] + lb[j];
                    { u32x2 w1; w1.x = pkh(x1[0], x1[1]); w1.y = pkh(x1[2], x1[3]); *(u32x2*)((char*)x1r + (of >> 1)) = w1; }
                    const f32x4 sh = lsh[j], sc = lsc[j];
                    const f32x4 hv = x1 * (sc + 1.0f) + sh;
                    u32x2 w; w.x = r8h(pkh(hv[0], hv[1])); w.y = r8h(pkh(hv[2], hv[3]));
                    *(u32x2*)((char*)h2r + (of >> 1)) = w;
                    *(LAS f32x4*)((LAS char*)h2f + lr * (HS * 4) + of) = hv; }
            }
            __syncthreads();
            const int e = tid & 31;
            { int lo_ = lane; asm volatile("" : "+v"(lo_));
              const int r16 = lo_ & 15, kq4 = lo_ >> 4;
              f32x4 c0 = (f32x4){0.f, 0.f, 0.f, 0.f}, c1 = (f32x4){0.f, 0.f, 0.f, 0.f};
              const float* wb = WRT + (size_t)r16 * D + wave * 256 + 4 * kq4;
              const LAS float* hb = h2f + r16 * HS + wave * 256 + 4 * kq4;
              f32x4 bw[4][2];
#pragma unroll
              for (int qt = 0; qt < 4; ++qt) {
#pragma unroll
                  for (int gg = 0; gg < 4; ++gg) { bw[gg][0] = *(const f32x4*)(wb + 16 * (4 * qt + gg)); bw[gg][1] = *(const f32x4*)(wb + 16 * D + 16 * (4 * qt + gg)); }
                  asm volatile("" : "+v"(bw[0][0]), "+v"(bw[0][1]), "+v"(bw[1][0]), "+v"(bw[1][1]), "+v"(bw[2][0]), "+v"(bw[2][1]), "+v"(bw[3][0]), "+v"(bw[3][1]));
#pragma unroll
                  for (int gg = 0; gg < 4; ++gg) {
                      const f32x4 a4 = *(const LAS f32x4*)(hb + 16 * (4 * qt + gg));
                      const f32x4 b0 = bw[gg][0], b1 = bw[gg][1];
#pragma unroll
                      for (int s = 0; s < 4; ++s) { c0 = __builtin_amdgcn_mfma_f32_16x16x4f32(a4[s], b0[s], c0, 0, 0, 0); c1 = __builtin_amdgcn_mfma_f32_16x16x4f32(a4[s], b1[s], c1, 0, 0, 0); }
                  }
              }
              __syncthreads();
              LAS float* part = (LAS float*)lds;
#pragma unroll
              for (int rg = 0; rg < 4; ++rg) { part[(wave * 16 + 4 * kq4 + rg) * 32 + r16] = c0[rg]; part[(wave * 16 + 4 * kq4 + rg) * 32 + 16 + r16] = c1[rg]; }
            }
            __syncthreads();
            LAS float* part = (LAS float*)lds;
            LAS int* selc = (LAS int*)(lds + 65536);
            { const int r = tid >> 5; float v = b_router[e];
#pragma unroll
              for (int q = 0; q < 8; ++q) v += part[(q * 16 + r) * 32 + e];
              float tv[4]; int ti[4]; int mine = 0;
#pragma unroll
              for (int k = 0; k < 4; ++k) { float bv = v; int bi = e;
#pragma unroll
#define T4_STEP(ctrl) do { const float ov = __builtin_bit_cast(float, __builtin_amdgcn_update_dpp(0, __builtin_bit_cast(int, bv), ctrl, 0xF, 0xF, false)); const int oi = __builtin_amdgcn_update_dpp(0, bi, ctrl, 0xF, 0xF, false); \
                      if (ov > bv || (ov == bv && oi < bi)) { bv = ov; bi = oi; } } while (0)
                  T4_STEP(0xB1); T4_STEP(0x4E); T4_STEP(0x141); T4_STEP(0x140);
#undef T4_STEP
                  { const float ov = __shfl_xor(bv, 16); const int oi = __shfl_xor(bi, 16); if (ov > bv || (ov == bv && oi < bi)) { bv = ov; bi = oi; } }
                  tv[k] = bv; ti[k] = bi; if (bi == e) { v = -3.0e38f; mine = 1; } }
              selc[r * 32 + e] = mine;
              if (e == 0) { const size_t row = (size_t)rb * 16 + r;
                  const float e1 = __expf(tv[1] - tv[0]), e2 = __expf(tv[2] - tv[0]), e3 = __expf(tv[3] - tv[0]), inv = 1.0f / (1.0f + e1 + e2 + e3);
                  *(int4*)(TOPI + row * 4) = make_int4(ti[0], ti[1], ti[2], ti[3]);
                  *(f32x4*)(TOPG + row * 4) = (f32x4){inv, e1 * inv, e2 * inv, e3 * inv}; } }
            __syncthreads();
            if (tid < NE) { int cnt = 0;
#pragma unroll
                for (int q = 0; q < 16; ++q) cnt += selc[q * 32 + tid];
                RBC[rb * NE + tid] = cnt; }
            __syncthreads();
        }
        if (BOTH(6) || rep + 1 < NREP(6)) GRID_BAR();
    } }

    if (IN(7)) { for (int rep = 0; rep < NREP(7); ++rep) {
        LAS int* part = (LAS int*)lds;
        LAS int* tstart = (LAS int*)(lds + 4096);
        LAS int* base = (LAS int*)(lds + 8192);
        LAS int* sel = (LAS int*)(lds + 12288);
        LAS int* red = (LAS int*)(lds + 16384);
        { const int e = tid & 31, pt = tid >> 5; int s = 0; for (int q = 0; q < 32; ++q) s += RBC[(pt * 32 + q) * NE + e]; part[pt * 32 + e] = s; }
        __syncthreads();
        if (tid == 0) { int acc = 0; for (int e = 0; e < NE; ++e) { int tot = 0; for (int pt = 0; pt < 16; ++pt) tot += part[pt * 32 + e]; tstart[e] = acc; tstart[40 + e] = tot; acc += (tot + 255) >> 8; } tstart[NE] = acc; }
        __syncthreads();
        if (bx == 0) { if (tid == 0) TEXP[0] = tstart[NE]; if (tid < NE) for (int t = tstart[tid]; t < tstart[tid + 1]; ++t) { const int left = tstart[40 + tid] - 256 * (t - tstart[tid]); TEXP[1 + t] = tid | ((left < 256 ? left : 256) << 8);
            const int R = tstart[tid + 1] - tstart[tid]; TEXP[512 + t] = (t - tstart[tid]) | (R << 8) | ((tstart[40 + tid] - 256 * (R - 1)) << 16); } }
        for (int rb = bx; rb < S / 16; rb += G) {
            { const int e = tid & 31, j = tid >> 5, pt = rb >> 5, q1 = pt * 32 + j, q2 = q1 + 16;
              int v = 0; if (q1 < rb) v += RBC[q1 * NE + e]; if (q2 < rb) v += RBC[q2 * NE + e]; red[j * 32 + e] = v; }
            if (tid >= 64 && tid < 128) sel[tid - 64] = TOPI[(size_t)rb * 64 + (tid - 64)];
            __syncthreads();
            if (tid < NE) { const int e = tid, pt = rb >> 5; int s = tstart[e] * 256; for (int q = 0; q < pt; ++q) s += part[q * 32 + e];
#pragma unroll
                for (int j = 0; j < 16; ++j) s += red[j * 32 + e];
                base[e] = s; }
            __syncthreads();
            if (tid < 64) { const int e = sel[tid]; int rank = 0;
#pragma unroll
                for (int q = 0; q < 64; ++q) rank += (q < tid && sel[q] == e) ? 1 : 0;
                const int pos = base[e] + rank, token = rb * 16 + (tid >> 2);
                TOK[pos] = token; GATEP[pos] = TOPG[(size_t)rb * 64 + tid]; POSOF[(size_t)rb * 64 + tid] = pos; }
            __syncthreads();
        }
        if (BOTH(7) || rep + 1 < NREP(7)) GRID_BAR();
    } }

    if (IN(8)) { for (int rep = 0; rep < NREP(8); ++rep) {
        LAS int* texp = (LAS int*)(lds + TEXP_OFF);
        const int NT = TEXP[0];
        for (int t = tid; t < CAP_TILES; t += NTHR) { texp[t] = t < NT ? TEXP[1 + t] : 0; texp[256 + t] = t < NT ? TEXP[512 + t] : 0; }
        __syncthreads();
        pg8::MoeOrder So{NT, NW1 / 256, G, bx, NW1, texp}; pg8::EpiSwiglu E{ACT, b_e1, 128, 64};
#if MK_ABL8 >= 0
        rg::moe_gemm<pg8::EpiSwiglu, pg8::MoeOrder, true, MK_ABL8>(lds, So, E, H2, TOK, w_e1, NW1); GRID_BAR();
#endif
        rg::moe_gemm<pg8::EpiSwiglu, pg8::MoeOrder, true>(lds, So, E, H2, TOK, w_e1, NW1);
        if (BOTH(8) || rep + 1 < NREP(8)) GRID_BAR();
    } }

    if (IN(9)) { for (int rep = 0; rep < NREP(9); ++rep) {
        LAS int* texp = (LAS int*)(lds + TEXP_OFF);
        const int NT = TEXP[0];
        for (int t = tid; t < CAP_TILES; t += NTHR) { texp[t] = t < NT ? TEXP[1 + t] : 0; texp[256 + t] = t < NT ? TEXP[512 + t] : 0; }
        __syncthreads();
        pg8::MoeOrder So{NT, D / 256, G, bx, D, texp}; pg8::EpiContrib E{CONTRIB, b_e2, GATEP, 128, 64};
        rg::moe_gemm<pg8::EpiContrib, pg8::MoeOrder, false>(lds, So, E, ACT, nullptr, w_e2, D);
        if (BOTH(9) || rep + 1 < NREP(9)) GRID_BAR();
    } }

    if (IN(10)) {
        unsigned bad = 0u;
        if (ONE) bad = (__hip_atomic_load(ctl + CW_BAR + XB_TMO, RLX_AGENT) != 0u) ? 1u : 0u;
        f32x4 g2v[8], l2g[8], l2b[8];
        { unsigned lo = (unsigned)lane * 16u; asm volatile("" : "+v"(lo));
#pragma unroll
          for (int j = 0; j < 8; ++j) { const unsigned of = lo + (unsigned)(j * 1024); g2v[j] = ldf4(ADA + 5 * D, of); l2g[j] = ldf4(ln2_g, of); l2b[j] = ldf4(ln2_b, of); } }
        u32x4 pcur = (u32x4){0u, 0u, 0u, 0u}; if (gw < S) pcur = *(const u32x4*)(POSOF + (size_t)gw * 4);
        for (int row = gw; row < S; row += NGW) {
            u32x4 pnext = pcur; if (row + NGW < S) pnext = *(const u32x4*)(POSOF + (size_t)(row + NGW) * 4);
            const int p0 = (int)pcur[0], p1 = (int)pcur[1], p2 = (int)pcur[2], p3 = (int)pcur[3];
            const bf16_t* c0r = CONTRIB + (size_t)p0 * D; const bf16_t* c1r = CONTRIB + (size_t)p1 * D; const bf16_t* c2r = CONTRIB + (size_t)p2 * D; const bf16_t* c3r = CONTRIB + (size_t)p3 * D;
            const bf16_t* xr = X1 + (size_t)row * D; float* orow = out + (size_t)row * D;
            unsigned lo16 = (unsigned)lane * 16u; asm volatile("" : "+v"(lo16));
            f32x4 v[8]; float s = 0.f;
#pragma unroll
            for (int hh = 0; hh < 2; ++hh) {
                u32x2 q0[4], q1[4], q2[4], q3[4]; f32x4 xv[4];
#pragma unroll
                for (int jj = 0; jj < 4; ++jj) { const unsigned of = lo16 + (unsigned)((4 * hh + jj) * 1024); q0[jj] = ldu2(c0r, of >> 1); q1[jj] = ldu2(c1r, of >> 1); q2[jj] = ldu2(c2r, of >> 1); q3[jj] = ldu2(c3r, of >> 1); xv[jj] = uph4(ldu2(xr, of >> 1)); }
                asm volatile("" : "+v"(q0[0]), "+v"(q0[1]), "+v"(q0[2]), "+v"(q0[3]), "+v"(q1[0]), "+v"(q1[1]), "+v"(q1[2]), "+v"(q1[3]), "+v"(q2[0]), "+v"(q2[1]), "+v"(q2[2]), "+v"(q2[3]),
                             "+v"(q3[0]), "+v"(q3[1]), "+v"(q3[2]), "+v"(q3[3]), "+v"(xv[0]), "+v"(xv[1]), "+v"(xv[2]), "+v"(xv[3]));
                if (hh == 0) asm volatile("" : "+v"(pnext));
#pragma unroll
                for (int jj = 0; jj < 4; ++jj) { const int j = 4 * hh + jj;
                    const u32x2 c0 = q0[jj], c1 = q1[jj], c2 = q2[jj], c3 = q3[jj];
                    f32x4 y;
                    y[0] = ((bflo(c0.x) + bflo(c1.x)) + bflo(c2.x)) + bflo(c3.x); y[1] = ((bfhi(c0.x) + bfhi(c1.x)) + bfhi(c2.x)) + bfhi(c3.x);
                    y[2] = ((bflo(c0.y) + bflo(c1.y)) + bflo(c2.y)) + bflo(c3.y); y[3] = ((bfhi(c0.y) + bfhi(c1.y)) + bfhi(c2.y)) + bfhi(c3.y);
                    v[j] = xv[jj] * ALPHA + g2v[j] * y;
                    s += (v[j][0] + v[j][1]) + (v[j][2] + v[j][3]); }
            }
            const float mean = wave_sum(s) * (1.0f / D); float s2 = 0.f;
#pragma unroll
            for (int j = 0; j < 8; ++j) { v[j] = v[j] - mean; s2 += (v[j][0] * v[j][0] + v[j][1] * v[j][1]) + (v[j][2] * v[j][2] + v[j][3] * v[j][3]); }
            const float rstd = 1.0f / sqrtf(wave_sum(s2) * (1.0f / D) + LN_EPS);
#pragma unroll
            for (int j = 0; j < 8; ++j) { const unsigned of = lo16 + (unsigned)(j * 1024);
                f32x4 o = v[j] * rstd * l2g[j] + l2b[j];
                if (bad) { const float qn = __builtin_nanf(""); o = (f32x4){qn, qn, qn, qn}; }
                *(f32x4*)((char*)orow + of) = o; }
            pcur = pnext;
        }
    }
#undef IN
#undef BOTH
#undef GRID_BAR
}

extern "C" void kernel_launch(void* const* d_in, const int* in_sizes, int n_in, void* d_out, int out_size, void* d_ws, size_t ws_size, hipStream_t stream) {
    static int grid = 0;
    if (grid == 0) {
        if (n_in != 20 || out_size != S * D || ws_size < WS_END) { fprintf(stderr, "kernel_launch: unexpected shapes (n_in %d, out %d, ws %zu)\n", n_in, out_size, ws_size); grid = -1; return; }
        int dev = 0, cus = 0, per_cu = 0;
        if (hipGetDevice(&dev) != hipSuccess || hipDeviceGetAttribute(&cus, hipDeviceAttributeMultiprocessorCount, dev) != hipSuccess) { grid = -1; return; }
        if (hipFuncSetAttribute((const void*)fwd_kernel, hipFuncAttributeMaxDynamicSharedMemorySize, LDS_BYTES) != hipSuccess) { fprintf(stderr, "kernel_launch: hipFuncSetAttribute failed\n"); grid = -1; return; }
        if (hipOccupancyMaxActiveBlocksPerMultiprocessor(&per_cu, (const void*)fwd_kernel, NTHR, LDS_BYTES) != hipSuccess || per_cu < 1) { fprintf(stderr, "kernel_launch: occupancy query says %d\n", per_cu); }
        (void)hipGetLastError();
        grid = cus;
    }
    if (grid < 0) return;
    (void)hipMemsetAsync((char*)d_ws + WS_CTL, 0, CTL_ZERO_BYTES, stream);
    Args a{};
    for (int i = 0; i < 20; ++i) a.in[i] = (const float*)d_in[i];
    a.out = (float*)d_out; a.ws = (unsigned char*)d_ws; a.pad = 0;
    if (MK_N_LAUNCHES == 1) {
        a.ph_lo = 0; a.ph_hi = NPH; a.li = 0;
        hipLaunchKernelGGL(fwd_kernel, dim3(grid), dim3(NTHR), LDS_BYTES, stream, a);
    } else {
        for (int p = 0; p < NPH; ++p) { a.ph_lo = p; a.ph_hi = p + 1; a.li = p; hipLaunchKernelGGL(fwd_kernel, dim3(grid), dim3(NTHR), LDS_BYTES, stream, a); }
    }
}
```
